# Optimizing an MI355X kernel written in HIP

```python
import math
import jax, jax.numpy as jnp
from jax import lax
import numpy as np

D_MODEL = 1024
BATCH = 8
SEQ = 2048
DEPTH = 1
DEC_BATCH = 128
DEC_SEQ = 1
PAST_LEN = 16384
PAGE_SIZE = 128

RWKV_WIDTH = D_MODEL // 2
RWKV_HEAD = 64
RWKV_HEADS = RWKV_WIDTH // RWKV_HEAD
DECAY_LORA = 32
AAA_LORA = 32
GATE_LORA = 64
LNX_EPS = 64e-5
S5_WIDTH = D_MODEL // 2
S5_GROUP = 16
S5_GROUPS = S5_WIDTH // S5_GROUP
S5_STATE = 64
D_FF = ((8 * D_MODEL // 3 + 255) // 256) * 256
NORM_EPS = 1e-6
SHIFT_COLS = 3 * RWKV_WIDTH + DECAY_LORA + AAA_LORA + GATE_LORA
PROJ_COLS = SHIFT_COLS + S5_WIDTH + 2 * D_MODEL

kernel_name = "rwkv7_s5_gated_parallel_decode_step"


def _rms_norm(x, g):
    xf = x.astype(jnp.float32)
    y = xf * lax.rsqrt(jnp.mean(xf * xf, axis=-1, keepdims=True) + NORM_EPS)
    return (y * g.astype(jnp.float32)).astype(x.dtype)


def _rwkv7_mix(xr, wkv0, w0, w_decay_up, a0, w_aaa_up, w_gate_up, k_k, k_a, r_k, lnx_g, lnx_b):
    Bn, T, _ = xr.shape
    H, N = RWKV_HEADS, RWKV_HEAD
    c0 = 3 * RWKV_WIDTH
    r = xr[..., :RWKV_WIDTH]
    k = xr[..., RWKV_WIDTH:2 * RWKV_WIDTH]
    v = xr[..., 2 * RWKV_WIDTH:c0]
    w_lo = xr[..., c0:c0 + DECAY_LORA]
    a_lo = xr[..., c0 + DECAY_LORA:c0 + DECAY_LORA + AAA_LORA]
    g_lo = xr[..., c0 + DECAY_LORA + AAA_LORA:]
    w = -jax.nn.softplus(-(w0 + jnp.tanh(w_lo) @ w_decay_up)) - 0.5
    decay = jnp.exp(-jnp.exp(w))
    a = jax.nn.sigmoid(a0 + a_lo @ w_aaa_up)
    g = jax.nn.sigmoid(g_lo) @ w_gate_up
    heads = lambda t: t.reshape(Bn, T, H, N)
    kk = heads(k * k_k)
    kk = kk * lax.rsqrt(jnp.maximum(jnp.sum(kk * kk, axis=-1, keepdims=True), 1e-24))
    k = heads(k * (1.0 + (a - 1.0) * k_a))
    r, v, decay, a = heads(r), heads(v), heads(decay), heads(a)

    def step(S, inp):
        r_t, w_t, k_t, v_t, kk_t, b_t = inp
        sa = jnp.einsum('bhvk,bhk->bhv', S, -kk_t)
        S = S * w_t[:, :, None, :] + sa[..., :, None] * b_t[..., None, :] + v_t[..., :, None] * k_t[..., None, :]
        return S, jnp.einsum('bhvk,bhk->bhv', S, r_t)

    tm = lambda t: jnp.moveaxis(t, 1, 0)
    wkv1, o = lax.scan(step, wkv0.astype(jnp.float32), (tm(r), tm(decay), tm(k), tm(v), tm(kk), tm(kk * a)))
    o = jnp.moveaxis(o, 0, 1)
    mu = jnp.mean(o, axis=-1, keepdims=True)
    var = jnp.mean(jnp.square(o - mu), axis=-1, keepdims=True)
    o = ((o - mu) * lax.rsqrt(var + LNX_EPS)).reshape(Bn, T, RWKV_WIDTH) * lnx_g + lnx_b
    bonus = jnp.sum(r * k * r_k.reshape(H, N), axis=-1, keepdims=True) * v
    o = (o + bonus.reshape(Bn, T, RWKV_WIDTH)) * g
    return o, wkv1


def _s5_mix(u, re0, im0, lam_re, lam_im, log_dt, b_re, b_im, c_re, c_im, d_skip, glu_w1, glu_b1, glu_w2, glu_b2):
    Bn, T, _ = u.shape
    lam_re = lam_re.astype(jnp.float32)
    lam_im = lam_im.astype(jnp.float32)
    dt = jnp.exp(log_dt.astype(jnp.float32))[:, None]
    mag = jnp.exp(lam_re * dt)
    ang = lam_im * dt
    lb_re, lb_im = mag * jnp.cos(ang), mag * jnp.sin(ang)
    nr, ni = lb_re - 1.0, lb_im
    den = lam_re * lam_re + lam_im * lam_im
    f_re = (nr * lam_re + ni * lam_im) / den
    f_im = (ni * lam_re - nr * lam_im) / den
    bb_re = f_re[..., None] * b_re - f_im[..., None] * b_im
    bb_im = f_re[..., None] * b_im + f_im[..., None] * b_re
    ug = u.reshape(Bn, T, S5_GROUPS, S5_GROUP)
    bu_re = jnp.einsum('gpc,btgc->btgp', bb_re, ug)
    bu_im = jnp.einsum('gpc,btgc->btgp', bb_im, ug)
    re0 = re0.astype(jnp.float32)
    im0 = im0.astype(jnp.float32)
    bu_re = bu_re.at[:, 0].add(lb_re * re0 - lb_im * im0)
    bu_im = bu_im.at[:, 0].add(lb_re * im0 + lb_im * re0)
    a_re = jnp.broadcast_to(lb_re, bu_re.shape)
    a_im = jnp.broadcast_to(lb_im, bu_im.shape)

    def combine(e1, e2):
        a1r, a1i, b1r, b1i = e1
        a2r, a2i, b2r, b2i = e2
        return (a1r * a2r - a1i * a2i, a1r * a2i + a1i * a2r,
                a2r * b1r - a2i * b1i + b2r, a2r * b1i + a2i * b1r + b2i)

    _, _, xs_re, xs_im = lax.associative_scan(combine, (a_re, a_im, bu_re, bu_im), axis=1)
    y = jnp.einsum('gcp,btgp->btgc', c_re, xs_re) - jnp.einsum('gcp,btgp->btgc', c_im, xs_im)
    y = y.reshape(Bn, T, S5_WIDTH) + d_skip * u
    hgl = jax.nn.gelu(y)
    out = (hgl @ glu_w1 + glu_b1) * jax.nn.sigmoid(hgl @ glu_w2 + glu_b2)
    return out, xs_re[:, -1], xs_im[:, -1]


def _layer(x, shift0, wkv0, s5re0, s5im0, norm_pre_mix, norm_post_mix, norm_pre_ffn, norm_post_ffn,
           w_in, mu_shift, w0, w_decay_up, a0, w_aaa_up, w_gate_up, k_k, k_a, r_k, lnx_g, lnx_b, w_rwkv_out,
           s5_lam_re, s5_lam_im, s5_log_dt, s5_b_re, s5_b_im, s5_c_re, s5_c_im, s5_d,
           glu_w1, glu_b1, glu_w2, glu_b2, w_merge_out, w_ffn_gate, w_ffn_up, w_ffn_down):
    h = _rms_norm(x, norm_pre_mix)
    p = (h @ w_in).astype(jnp.float32)
    pr = p[..., :SHIFT_COLS]
    pr_prev = jnp.concatenate([shift0.astype(jnp.float32)[:, None, :], pr[:, :-1]], axis=1)
    xr = pr + (pr_prev - pr) * mu_shift
    oa, wkv1 = _rwkv7_mix(xr, wkv0, w0, w_decay_up, a0, w_aaa_up, w_gate_up, k_k, k_a, r_k, lnx_g, lnx_b)
    u = p[..., SHIFT_COLS:SHIFT_COLS + S5_WIDTH]
    ob, re1, im1 = _s5_mix(u, s5re0, s5im0, s5_lam_re, s5_lam_im, s5_log_dt, s5_b_re, s5_b_im,
                           s5_c_re, s5_c_im, s5_d, glu_w1, glu_b1, glu_w2, glu_b2)
    g_off = SHIFT_COLS + S5_WIDTH
    gate_a = jax.nn.sigmoid(p[..., g_off:g_off + D_MODEL])
    gate_b = jax.nn.sigmoid(p[..., g_off + D_MODEL:g_off + 2 * D_MODEL])
    merged = gate_a * (oa @ w_rwkv_out) + gate_b * ob
    mix = merged @ w_merge_out
    x = x + _rms_norm(mix, norm_post_mix).astype(x.dtype)
    h = _rms_norm(x, norm_pre_ffn)
    f = (jax.nn.silu(h @ w_ffn_gate) * (h @ w_ffn_up)) @ w_ffn_down
    x = x + _rms_norm(f, norm_post_ffn).astype(x.dtype)
    return x, pr[:, -1], wkv1, re1, im1


def setup_inputs(seed: int = 0) -> dict:
    key = jax.random.key(seed)
    ks = iter(jax.random.split(key, 64))
    L = DEPTH

    def nrm(shape, s):
        return jax.random.normal(next(ks), shape, jnp.float32) * s

    def unif(shape, lo, hi):
        return jax.random.uniform(next(ks), shape, jnp.float32, lo, hi)

    ramp = jnp.arange(RWKV_WIDTH, dtype=jnp.float32) / (RWKV_WIDTH - 1)
    n_state = jnp.arange(S5_STATE, dtype=jnp.float32)
    return {
        "x_prompt": nrm((BATCH, SEQ, D_MODEL), 1.0),
        "x_sample": nrm((DEC_BATCH, DEC_SEQ, D_MODEL), 1.0),
        "state_shift": nrm((L, DEC_BATCH, SHIFT_COLS), 1.0),
        "state_wkv": nrm((L, DEC_BATCH, RWKV_HEADS, RWKV_HEAD, RWKV_HEAD), 0.3),
        "state_s5_re": nrm((L, DEC_BATCH, S5_GROUPS, S5_STATE), 0.5),
        "state_s5_im": nrm((L, DEC_BATCH, S5_GROUPS, S5_STATE), 0.5),
        "norm_pre_mix": 1.0 + nrm((L, D_MODEL), 0.05),
        "norm_post_mix": 1.0 + nrm((L, D_MODEL), 0.05),
        "norm_pre_ffn": 1.0 + nrm((L, D_MODEL), 0.05),
        "norm_post_ffn": 1.0 + nrm((L, D_MODEL), 0.05),
        "w_in": nrm((L, D_MODEL, PROJ_COLS), D_MODEL ** -0.5),
        "mu_shift": unif((L, SHIFT_COLS), 0.0, 1.0),
        "w0": (-6.0 + 5.0 * ramp ** 0.7)[None, :] + nrm((L, RWKV_WIDTH), 0.1),
        "w_decay_up": nrm((L, DECAY_LORA, RWKV_WIDTH), 0.1),
        "a0": nrm((L, RWKV_WIDTH), 0.1),
        "w_aaa_up": nrm((L, AAA_LORA, RWKV_WIDTH), 0.1),
        "w_gate_up": nrm((L, GATE_LORA, RWKV_WIDTH), GATE_LORA ** -0.5),
        "k_k": 0.85 + nrm((L, RWKV_WIDTH), 0.05),
        "k_a": 1.0 + nrm((L, RWKV_WIDTH), 0.05),
        "r_k": nrm((L, RWKV_WIDTH), 0.1),
        "lnx_g": 1.0 + nrm((L, RWKV_WIDTH), 0.05),
        "lnx_b": nrm((L, RWKV_WIDTH), 0.01),
        "w_rwkv_out": nrm((L, RWKV_WIDTH, D_MODEL), RWKV_WIDTH ** -0.5),
        "s5_lam_re": -0.5 + nrm((L, S5_GROUPS, S5_STATE), 0.01),
        "s5_lam_im": (math.pi * n_state)[None, None, :] + nrm((L, S5_GROUPS, S5_STATE), 0.01),
        "s5_log_dt": unif((L, S5_GROUPS), math.log(1e-3), math.log(1e-1)),
        "s5_b_re": nrm((L, S5_GROUPS, S5_STATE, S5_GROUP), (2 * S5_GROUP) ** -0.5),
        "s5_b_im": nrm((L, S5_GROUPS, S5_STATE, S5_GROUP), (2 * S5_GROUP) ** -0.5),
        "s5_c_re": nrm((L, S5_GROUPS, S5_GROUP, S5_STATE), S5_STATE ** -0.5),
        "s5_c_im": nrm((L, S5_GROUPS, S5_GROUP, S5_STATE), S5_STATE ** -0.5),
        "s5_d": nrm((L, S5_WIDTH), 1.0),
        "glu_w1": nrm((L, S5_WIDTH, D_MODEL), S5_WIDTH ** -0.5),
        "glu_b1": nrm((L, D_MODEL), 0.01),
        "glu_w2": nrm((L, S5_WIDTH, D_MODEL), S5_WIDTH ** -0.5),
        "glu_b2": nrm((L, D_MODEL), 0.01),
        "w_merge_out": nrm((L, D_MODEL, D_MODEL), D_MODEL ** -0.5),
        "w_ffn_gate": nrm((L, D_MODEL, D_FF), D_MODEL ** -0.5),
        "w_ffn_up": nrm((L, D_MODEL, D_FF), D_MODEL ** -0.5),
        "w_ffn_down": nrm((L, D_FF, D_MODEL), D_FF ** -0.5),
    }


def reference(x_prompt, x_sample, state_shift, state_wkv, state_s5_re, state_s5_im,
              norm_pre_mix, norm_post_mix, norm_pre_ffn, norm_post_ffn, w_in, mu_shift,
              w0, w_decay_up, a0, w_aaa_up, w_gate_up, k_k, k_a, r_k, lnx_g, lnx_b, w_rwkv_out,
              s5_lam_re, s5_lam_im, s5_log_dt, s5_b_re, s5_b_im, s5_c_re, s5_c_im, s5_d,
              glu_w1, glu_b1, glu_w2, glu_b2, w_merge_out, w_ffn_gate, w_ffn_up, w_ffn_down):
    yp, ys = x_prompt, x_sample
    sh_p, wkv_p, re_p, im_p = [], [], [], []
    sh_s, wkv_s, re_s, im_s = [], [], [], []
    for l in range(DEPTH):
        lw = (norm_pre_mix[l], norm_post_mix[l], norm_pre_ffn[l], norm_post_ffn[l], w_in[l], mu_shift[l],
              w0[l], w_decay_up[l], a0[l], w_aaa_up[l], w_gate_up[l], k_k[l], k_a[l], r_k[l], lnx_g[l], lnx_b[l],
              w_rwkv_out[l], s5_lam_re[l], s5_lam_im[l], s5_log_dt[l], s5_b_re[l], s5_b_im[l], s5_c_re[l],
              s5_c_im[l], s5_d[l], glu_w1[l], glu_b1[l], glu_w2[l], glu_b2[l], w_merge_out[l],
              w_ffn_gate[l], w_ffn_up[l], w_ffn_down[l])
        zp_shift = jnp.zeros((x_prompt.shape[0], SHIFT_COLS), jnp.float32)
        zp_wkv = jnp.zeros((x_prompt.shape[0], RWKV_HEADS, RWKV_HEAD, RWKV_HEAD), jnp.float32)
        zp_s5 = jnp.zeros((x_prompt.shape[0], S5_GROUPS, S5_STATE), jnp.float32)
        yp, a1, a2, a3, a4 = _layer(yp, zp_shift, zp_wkv, zp_s5, zp_s5, *lw)
        sh_p.append(a1); wkv_p.append(a2); re_p.append(a3); im_p.append(a4)
        ys, b1, b2, b3, b4 = _layer(ys, state_shift[l], state_wkv[l], state_s5_re[l], state_s5_im[l], *lw)
        sh_s.append(b1); wkv_s.append(b2); re_s.append(b3); im_s.append(b4)
    dt_p, dt_s = x_prompt.dtype, x_sample.dtype
    new_shift_prompt = jnp.stack(sh_p).astype(dt_p)
    new_wkv_prompt = jnp.stack(wkv_p).astype(dt_p)
    new_s5_re_prompt = jnp.stack(re_p).astype(dt_p)
    new_s5_im_prompt = jnp.stack(im_p).astype(dt_p)
    new_shift_sample = jnp.stack(sh_s).astype(dt_s)
    new_wkv_sample = jnp.stack(wkv_s).astype(dt_s)
    new_s5_re_sample = jnp.stack(re_s).astype(dt_s)
    new_s5_im_sample = jnp.stack(im_s).astype(dt_s)
    return (yp, ys, new_shift_prompt, new_wkv_prompt, new_s5_re_prompt, new_s5_im_prompt,
            new_shift_sample, new_wkv_sample, new_s5_re_sample, new_s5_im_sample)
```

```cpp
#include <hip/hip_runtime.h>
#include <cstdint>
#include <cstdio>

constexpr int D = 1024, NB = 8, T = 2048, NS = 128;
constexpr int MP = NB * T;
constexpr int M = MP + NS;
constexpr int RW = 512, HN = 64, NH = 8;
constexpr int SHIFT = 1664, PROJ = 4224;
constexpr int SG = 32, SP = 64, SC = 16;
constexpr int FF = 2816;
constexpr float NORM_EPS = 1e-6f, LNX_EPS = 64e-5f;

typedef unsigned short bf16;
__device__ __forceinline__ float bf2f(bf16 v) { return __uint_as_float((unsigned)v << 16); }
__device__ __forceinline__ bf16 f2bf(float f) { unsigned u = __float_as_uint(f); return (bf16)((u + 0x7fffu + ((u >> 16) & 1u)) >> 16); }
__device__ __forceinline__ float wave_sum(float v) {
#pragma unroll
    for (int o = 1; o < 64; o <<= 1) v += __shfl_xor(v, o);
    return v;
}
__device__ __forceinline__ float sigmoidf_(float x) { return 1.f / (1.f + __expf(-x)); }

constexpr size_t O_Y = 0;
constexpr size_t O_SHIFT_P = (size_t)M * D;
constexpr size_t O_WKV_P = O_SHIFT_P + (size_t)NB * SHIFT;
constexpr size_t O_S5RE_P = O_WKV_P + (size_t)NB * NH * HN * HN;
constexpr size_t O_S5IM_P = O_S5RE_P + (size_t)NB * SG * SP;
constexpr size_t O_SHIFT_S = O_S5IM_P + (size_t)NB * SG * SP;
constexpr size_t O_WKV_S = O_SHIFT_S + (size_t)NS * SHIFT;
constexpr size_t O_S5RE_S = O_WKV_S + (size_t)NS * NH * HN * HN;
constexpr size_t O_S5IM_S = O_S5RE_S + (size_t)NS * SG * SP;
constexpr size_t O_END = O_S5IM_S + (size_t)NS * SG * SP;
static_assert(O_END == 22148096, "d_out size");

constexpr size_t MiB = 1u << 20;
constexpr size_t WS_XN = 33 * MiB;
constexpr size_t WS_PR = 66 * MiB;
constexpr size_t WS_U = 119 * MiB;
constexpr size_t WS_GATES = 136 * MiB;
constexpr size_t WS_OA = 217 * MiB;
constexpr size_t WS_HGL = 234 * MiB;
constexpr size_t WS_MERGED = WS_XN;
constexpr size_t WS_MIX = WS_PR;
constexpr size_t WS_H2 = WS_XN;
constexpr size_t WS_HFF = WS_PR;
constexpr size_t WS_F = 156 * MiB;

struct P {
    const float* in[39];
    float* out;
    unsigned char* ws;
};

__device__ __forceinline__ const float* xrow(const P& p, int r) { return r < MP ? p.in[0] + (size_t)r * D : p.in[1] + (size_t)(r - MP) * D; }

__global__ void __launch_bounds__(256) k_xnorm(P p) {
    const int lane = threadIdx.x & 63, w = threadIdx.x >> 6;
    const float* g = p.in[6];
    bf16* xn = (bf16*)(p.ws + WS_XN);
    for (int r = blockIdx.x * 4 + w; r < M; r += gridDim.x * 4) {
        const float* x = xrow(p, r);
        float v[16]; float s = 0.f;
#pragma unroll
        for (int j = 0; j < 16; ++j) { v[j] = x[lane + 64 * j]; s += v[j] * v[j]; }
        s = wave_sum(s);
        const float rs = rsqrtf(s * (1.f / D) + NORM_EPS);
#pragma unroll
        for (int j = 0; j < 16; ++j) xn[(size_t)r * D + lane + 64 * j] = f2bf(v[j] * rs * g[lane + 64 * j]);
    }
}

template <int NW> struct GemmArgs { const bf16* A[NW]; const float* W[NW]; int lda[NW]; int K[NW]; int Mrows, N; };
template <int NW, class Epi>
__device__ __forceinline__ void gemm_tile(const GemmArgs<NW>& g, const Epi& epi, int tm, int tn, float (*As)[68], float (*Ws)[64]) {
    const int tid = threadIdx.x, tx = tid & 15, ty = tid >> 4;
    float acc[NW][4][4];
#pragma unroll
    for (int w = 0; w < NW; ++w)
#pragma unroll
        for (int i = 0; i < 4; ++i)
#pragma unroll
            for (int j = 0; j < 4; ++j) acc[w][i][j] = 0.f;
#pragma unroll
    for (int w = 0; w < NW; ++w) {
        for (int k0 = 0; k0 < g.K[w]; k0 += 16) {
            __syncthreads();
#pragma unroll
            for (int i = 0; i < 4; ++i) { const int e = tid + 256 * i, r = e >> 4, k = e & 15; const int row = tm * 64 + r;
                As[k][r] = row < g.Mrows ? bf2f(g.A[w][(size_t)row * g.lda[w] + k0 + k]) : 0.f; }
#pragma unroll
            for (int i = 0; i < 4; ++i) { const int e = tid + 256 * i, k = e >> 6, c = e & 63; const int col = tn * 64 + c;
                Ws[k][c] = col < g.N ? g.W[w][(size_t)(k0 + k) * g.N + col] : 0.f; }
            __syncthreads();
#pragma unroll
            for (int k = 0; k < 16; ++k) {
                float a[4], b[4];
#pragma unroll
                for (int i = 0; i < 4; ++i) a[i] = As[k][ty * 4 + i];
#pragma unroll
                for (int j = 0; j < 4; ++j) b[j] = Ws[k][tx * 4 + j];
#pragma unroll
                for (int i = 0; i < 4; ++i)
#pragma unroll
                    for (int j = 0; j < 4; ++j) acc[w][i][j] += a[i] * b[j];
            }
        }
    }
#pragma unroll
    for (int i = 0; i < 4; ++i)
#pragma unroll
        for (int j = 0; j < 4; ++j) {
            const int row = tm * 64 + ty * 4 + i, col = tn * 64 + tx * 4 + j;
            if (row < g.Mrows && col < g.N) {
                if constexpr (NW == 1) epi(row, col, acc[0][i][j], 0.f, 0.f);
                else if constexpr (NW == 2) epi(row, col, acc[0][i][j], acc[1][i][j], 0.f);
                else epi(row, col, acc[0][i][j], acc[1][i][j], acc[2][i][j]);
            }
        }
}
template <int NW, class Epi>
__global__ void __launch_bounds__(256) k_gemm(GemmArgs<NW> g, Epi epi) {
    __shared__ float As[16][68];
    __shared__ float Ws[16][64];
    const int ntm = (g.Mrows + 63) / 64, ntn = (g.N + 63) / 64;
    for (int t = blockIdx.x; t < ntm * ntn; t += gridDim.x) gemm_tile<NW, Epi>(g, epi, t / ntn, t % ntn, As, Ws);
}

struct EpiProj {
    bf16 *pr, *u, *gates; float* out;
    __device__ void operator()(int row, int col, float x, float, float) const {
        if (col < SHIFT) {
            pr[(size_t)row * SHIFT + col] = f2bf(x);
            if (row < MP) { if ((row % T) == T - 1) out[O_SHIFT_P + (size_t)(row / T) * SHIFT + col] = x; }
            else out[O_SHIFT_S + (size_t)(row - MP) * SHIFT + col] = x;
        } else if (col < SHIFT + 512) u[(size_t)row * 512 + (col - SHIFT)] = f2bf(x);
        else gates[(size_t)row * 2048 + (col - SHIFT - 512)] = f2bf(sigmoidf_(x));
    }
};
struct EpiMerge {
    const bf16* gates; const float *b1, *b2; bf16* merged;
    __device__ void operator()(int row, int col, float v0, float v1, float v2) const {
        const float ga = bf2f(gates[(size_t)row * 2048 + col]), gb = bf2f(gates[(size_t)row * 2048 + 1024 + col]);
        const float glu = (v1 + b1[col]) * sigmoidf_(v2 + b2[col]);
        merged[(size_t)row * D + col] = f2bf(ga * v0 + gb * glu);
    }
};
struct EpiF32 { float* o; int ld; __device__ void operator()(int row, int col, float v0, float, float) const { o[(size_t)row * ld + col] = v0; } };
struct EpiSwiglu { bf16* o; __device__ void operator()(int row, int col, float gt, float up, float) const { o[(size_t)row * FF + col] = f2bf(gt * sigmoidf_(gt) * up); } };

__global__ void __launch_bounds__(64) k_rwkv(P p) {
    __shared__ float lw[128][64];
    const int lane = threadIdx.x;
    const int seq = blockIdx.x / NH, h = blockIdx.x % NH;
    const bool prompt = seq < NB;
    const int nT = prompt ? T : 1, row0 = prompt ? seq * T : MP + (seq - NB);
    const int ch = h * HN + lane;
    const bf16* pr = (const bf16*)(p.ws + WS_PR);
    bf16* oa = (bf16*)(p.ws + WS_OA);
    const float* mu = p.in[11];
    for (int j = 0; j < 32; ++j) { lw[j][lane] = p.in[13][(size_t)j * RW + ch]; lw[32 + j][lane] = p.in[15][(size_t)j * RW + ch]; }
    for (int j = 0; j < 64; ++j) lw[64 + j][lane] = p.in[16][(size_t)j * RW + ch];
    __syncthreads();
    const float w0 = p.in[12][ch], a0 = p.in[14][ch], kk_w = p.in[17][ch], ka_w = p.in[18][ch], rk_w = p.in[19][ch], lng = p.in[20][ch], lnb = p.in[21][ch];
    const float mu_r = mu[ch], mu_k = mu[RW + ch], mu_v = mu[2 * RW + ch], mu_l1 = mu[3 * RW + lane], mu_l2 = mu[3 * RW + 64 + lane];
    float S[HN];
    float pr_r, pr_k, pr_v, pr_l1, pr_l2;
    if (prompt) {
#pragma unroll
        for (int k = 0; k < HN; ++k) S[k] = 0.f;
        pr_r = pr_k = pr_v = pr_l1 = pr_l2 = 0.f;
    } else {
        const int sb = seq - NB;
        const float* st = p.in[3] + ((size_t)sb * NH + h) * HN * HN + (size_t)lane * HN;
#pragma unroll
        for (int k = 0; k < HN; ++k) S[k] = st[k];
        const float* sh = p.in[2] + (size_t)sb * SHIFT;
        pr_r = sh[ch]; pr_k = sh[RW + ch]; pr_v = sh[2 * RW + ch]; pr_l1 = sh[3 * RW + lane]; pr_l2 = sh[3 * RW + 64 + lane];
    }
    for (int t = 0; t < nT; ++t) {
        const bf16* prow = pr + (size_t)(row0 + t) * SHIFT;
        const float c_r = bf2f(prow[ch]), c_k = bf2f(prow[RW + ch]), c_v = bf2f(prow[2 * RW + ch]), c_l1 = bf2f(prow[3 * RW + lane]), c_l2 = bf2f(prow[3 * RW + 64 + lane]);
        const float r = c_r + (pr_r - c_r) * mu_r, k = c_k + (pr_k - c_k) * mu_k, v = c_v + (pr_v - c_v) * mu_v;
        const float l1 = c_l1 + (pr_l1 - c_l1) * mu_l1, l2 = c_l2 + (pr_l2 - c_l2) * mu_l2;
        pr_r = c_r; pr_k = c_k; pr_v = c_v; pr_l1 = c_l1; pr_l2 = c_l2;
        const float in1 = lane < 32 ? tanhf(l1) : l1;
        const float in2 = sigmoidf_(l2);
        float sw = 0.f, sa_ = 0.f, sg = 0.f;
#pragma unroll 8
        for (int j = 0; j < 32; ++j) { sw += __shfl(in1, j) * lw[j][lane]; sa_ += __shfl(in1, 32 + j) * lw[32 + j][lane]; }
#pragma unroll 8
        for (int j = 0; j < 64; ++j) sg += __shfl(in2, j) * lw[64 + j][lane];
        const float z = -(w0 + sw);
        const float sp = fmaxf(z, 0.f) + log1pf(__expf(-fabsf(z)));
        const float wlog = -sp - 0.5f;
        const float dec = __expf(-__expf(wlog));
        const float a = sigmoidf_(a0 + sa_);
        const float g = sg;
        float kkv = k * kk_w;
        const float nrm = wave_sum(kkv * kkv);
        kkv = kkv * rsqrtf(fmaxf(nrm, 1e-24f));
        const float kp = k * (1.f + (a - 1.f) * ka_w);
        const float bv = kkv * a;
        float sa = 0.f;
#pragma unroll
        for (int kx = 0; kx < HN; ++kx) sa -= S[kx] * __shfl(kkv, kx);
        float o = 0.f;
#pragma unroll
        for (int kx = 0; kx < HN; ++kx) {
            S[kx] = S[kx] * __shfl(dec, kx) + sa * __shfl(bv, kx) + v * __shfl(kp, kx);
            o += S[kx] * __shfl(r, kx);
        }
        const float mean = wave_sum(o) * (1.f / HN);
        const float dlt = o - mean;
        const float var = wave_sum(dlt * dlt) * (1.f / HN);
        float on = dlt * rsqrtf(var + LNX_EPS) * lng + lnb;
        const float bonus = wave_sum(r * kp * rk_w) * v;
        on = (on + bonus) * g;
        oa[(size_t)(row0 + t) * RW + ch] = f2bf(on);
    }
    float* so = prompt ? p.out + O_WKV_P + ((size_t)seq * NH + h) * HN * HN : p.out + O_WKV_S + ((size_t)(seq - NB) * NH + h) * HN * HN;
#pragma unroll
    for (int k = 0; k < HN; ++k) so[(size_t)lane * HN + k] = S[k];
}

__device__ __forceinline__ float gelu_tanh(float x) { const float c = 0.7978845608028654f; return 0.5f * x * (1.f + tanhf(c * (x + 0.044715f * x * x * x))); }
__global__ void __launch_bounds__(64) k_s5(P p) {
    const int lane = threadIdx.x;
    const int seq = blockIdx.x / SG, g = blockIdx.x % SG;
    const bool prompt = seq < NB;
    const int nT = prompt ? T : 1, row0 = prompt ? seq * T : MP + (seq - NB);
    const bf16* u = (const bf16*)(p.ws + WS_U);
    bf16* hgl = (bf16*)(p.ws + WS_HGL);
    const float lre = p.in[23][g * SP + lane], lim = p.in[24][g * SP + lane], dt = __expf(p.in[25][g]);
    const float mag = __expf(lre * dt), ang = lim * dt;
    const float lbr = mag * cosf(ang), lbi = mag * sinf(ang);
    const float nr = lbr - 1.f, ni = lbi, den = lre * lre + lim * lim;
    const float fre = (nr * lre + ni * lim) / den, fim = (ni * lre - nr * lim) / den;
    float bbr[SC], bbi[SC], cr[SC], ci[SC];
#pragma unroll
    for (int c = 0; c < SC; ++c) {
        const float br = p.in[26][((size_t)g * SP + lane) * SC + c], bi = p.in[27][((size_t)g * SP + lane) * SC + c];
        bbr[c] = fre * br - fim * bi; bbi[c] = fre * bi + fim * br;
        cr[c] = p.in[28][((size_t)g * SC + c) * SP + lane]; ci[c] = p.in[29][((size_t)g * SC + c) * SP + lane];
    }
    const float dsk = lane < SC ? p.in[30][g * SC + lane] : 0.f;
    float xr = 0.f, xi = 0.f;
    if (!prompt) { xr = p.in[4][((size_t)(seq - NB) * SG + g) * SP + lane]; xi = p.in[5][((size_t)(seq - NB) * SG + g) * SP + lane]; }
    for (int t = 0; t < nT; ++t) {
        const float uv = lane < SC ? bf2f(u[(size_t)(row0 + t) * 512 + g * SC + lane]) : 0.f;
        float bur = 0.f, bui = 0.f;
#pragma unroll
        for (int c = 0; c < SC; ++c) { const float uc = __shfl(uv, c); bur += bbr[c] * uc; bui += bbi[c] * uc; }
        const float nxr = lbr * xr - lbi * xi + bur, nxi = lbr * xi + lbi * xr + bui;
        xr = nxr; xi = nxi;
        float y = 0.f;
#pragma unroll
        for (int c = 0; c < SC; ++c) { const float s = wave_sum(cr[c] * xr - ci[c] * xi); if (lane == c) y = s; }
        if (lane < SC) { y += dsk * uv; hgl[(size_t)(row0 + t) * 512 + g * SC + lane] = f2bf(gelu_tanh(y)); }
    }
    float* ore = prompt ? p.out + O_S5RE_P + ((size_t)seq * SG + g) * SP : p.out + O_S5RE_S + ((size_t)(seq - NB) * SG + g) * SP;
    float* oim = prompt ? p.out + O_S5IM_P + ((size_t)seq * SG + g) * SP : p.out + O_S5IM_S + ((size_t)(seq - NB) * SG + g) * SP;
    ore[lane] = xr; oim[lane] = xi;
}

__global__ void __launch_bounds__(256) k_row1(P p) {
    const int lane = threadIdx.x & 63, w = threadIdx.x >> 6;
    const float *g1 = p.in[7], *g2 = p.in[8];
    const float* mix = (const float*)(p.ws + WS_MIX);
    bf16* h2 = (bf16*)(p.ws + WS_H2);
    for (int r = blockIdx.x * 4 + w; r < M; r += gridDim.x * 4) {
        const float* x = xrow(p, r);
        float v[16]; float s = 0.f;
#pragma unroll
        for (int j = 0; j < 16; ++j) { v[j] = mix[(size_t)r * D + lane + 64 * j]; s += v[j] * v[j]; }
        s = wave_sum(s);
        const float rs = rsqrtf(s * (1.f / D) + NORM_EPS);
        float s2 = 0.f;
#pragma unroll
        for (int j = 0; j < 16; ++j) { v[j] = x[lane + 64 * j] + v[j] * rs * g1[lane + 64 * j]; s2 += v[j] * v[j]; }
        s2 = wave_sum(s2);
        const float rs2 = rsqrtf(s2 * (1.f / D) + NORM_EPS);
#pragma unroll
        for (int j = 0; j < 16; ++j) { p.out[(size_t)r * D + lane + 64 * j] = v[j]; h2[(size_t)r * D + lane + 64 * j] = f2bf(v[j] * rs2 * g2[lane + 64 * j]); }
    }
}
__global__ void __launch_bounds__(256) k_row2(P p) {
    const int lane = threadIdx.x & 63, w = threadIdx.x >> 6;
    const float* g3 = p.in[9];
    const float* f = (const float*)(p.ws + WS_F);
    for (int r = blockIdx.x * 4 + w; r < M; r += gridDim.x * 4) {
        float v[16]; float s = 0.f;
#pragma unroll
        for (int j = 0; j < 16; ++j) { v[j] = f[(size_t)r * D + lane + 64 * j]; s += v[j] * v[j]; }
        s = wave_sum(s);
        const float rs = rsqrtf(s * (1.f / D) + NORM_EPS);
#pragma unroll
        for (int j = 0; j < 16; ++j) { const size_t i = (size_t)r * D + lane + 64 * j; p.out[i] = p.out[i] + v[j] * rs * g3[lane + 64 * j]; }
    }
}

extern "C" void kernel_launch(void* const* d_in, const int* in_sizes, int n_in, void* d_out, int out_size, void* d_ws, size_t ws_size, hipStream_t stream) {
    if (n_in != 39 || out_size != (int)O_END || ws_size < 256 * MiB) { fprintf(stderr, "kernel_launch: unexpected sizes n_in %d out %d ws %zu\n", n_in, out_size, ws_size); return; }
    P p{};
    for (int i = 0; i < 39; ++i) p.in[i] = (const float*)d_in[i];
    p.out = (float*)d_out; p.ws = (unsigned char*)d_ws;
    unsigned char* ws = p.ws;
    const int G = 2048;
    k_xnorm<<<G, 256, 0, stream>>>(p);
    { GemmArgs<1> g{}; g.A[0] = (const bf16*)(ws + WS_XN); g.lda[0] = D; g.W[0] = p.in[10]; g.K[0] = D; g.Mrows = M; g.N = PROJ;
      EpiProj e{(bf16*)(ws + WS_PR), (bf16*)(ws + WS_U), (bf16*)(ws + WS_GATES), p.out};
      k_gemm<1, EpiProj><<<G, 256, 0, stream>>>(g, e); }
    k_rwkv<<<(NB + NS) * NH, 64, 0, stream>>>(p);
    k_s5<<<(NB + NS) * SG, 64, 0, stream>>>(p);
    { GemmArgs<3> g{}; g.A[0] = (const bf16*)(ws + WS_OA); g.lda[0] = RW; g.W[0] = p.in[22]; g.K[0] = RW;
      g.A[1] = (const bf16*)(ws + WS_HGL); g.lda[1] = 512; g.W[1] = p.in[31]; g.K[1] = 512;
      g.A[2] = (const bf16*)(ws + WS_HGL); g.lda[2] = 512; g.W[2] = p.in[33]; g.K[2] = 512; g.Mrows = M; g.N = D;
      EpiMerge e{(const bf16*)(ws + WS_GATES), p.in[32], p.in[34], (bf16*)(ws + WS_MERGED)};
      k_gemm<3, EpiMerge><<<G, 256, 0, stream>>>(g, e); }
    { GemmArgs<1> g{}; g.A[0] = (const bf16*)(ws + WS_MERGED); g.lda[0] = D; g.W[0] = p.in[35]; g.K[0] = D; g.Mrows = M; g.N = D;
      EpiF32 e{(float*)(ws + WS_MIX), D};
      k_gemm<1, EpiF32><<<G, 256, 0, stream>>>(g, e); }
    k_row1<<<G, 256, 0, stream>>>(p);
    { GemmArgs<2> g{}; g.A[0] = (const bf16*)(ws + WS_H2); g.lda[0] = D; g.W[0] = p.in[36]; g.K[0] = D;
      g.A[1] = (const bf16*)(ws + WS_H2); g.lda[1] = D; g.W[1] = p.in[37]; g.K[1] = D; g.Mrows = M; g.N = FF;
      EpiSwiglu e{(bf16*)(ws + WS_HFF)};
      k_gemm<2, EpiSwiglu><<<G, 256, 0, stream>>>(g, e); }
    { GemmArgs<1> g{}; g.A[0] = (const bf16*)(ws + WS_HFF); g.lda[0] = FF; g.W[0] = p.in[38]; g.K[0] = FF; g.Mrows = M; g.N = D;
      EpiF32 e{(float*)(ws + WS_F), D};
      k_gemm<1, EpiF32><<<G, 256, 0, stream>>>(g, e); }
    k_row2<<<G, 256, 0, stream>>>(p);
}
```

```cpp
#include <hip/hip_runtime.h>
#include <cstdint>
#include <cstdio>

constexpr int D = 1024, NB = 8, T = 2048, NS = 128;
constexpr int MP = NB * T;
constexpr int M = MP + NS;
constexpr int RW = 512, HN = 64, NH = 8;
constexpr int SHIFT = 1664, PROJ = 4224;
constexpr int SG = 32, SP = 64, SC = 16;
constexpr int FF = 2816;
constexpr float NORM_EPS = 1e-6f, LNX_EPS = 64e-5f;

typedef unsigned short bf16;
__device__ __forceinline__ float bf2f(bf16 v) { return __uint_as_float((unsigned)v << 16); }
__device__ __forceinline__ bf16 f2bf(float f) { unsigned u = __float_as_uint(f); return (bf16)((u + 0x7fffu + ((u >> 16) & 1u)) >> 16); }
__device__ __forceinline__ float wave_sum(float v) {
#pragma unroll
    for (int o = 1; o < 64; o <<= 1) v += __shfl_xor(v, o);
    return v;
}
__device__ __forceinline__ float sigmoidf_(float x) { return 1.f / (1.f + __expf(-x)); }

constexpr size_t O_Y = 0;
constexpr size_t O_SHIFT_P = (size_t)M * D;
constexpr size_t O_WKV_P = O_SHIFT_P + (size_t)NB * SHIFT;
constexpr size_t O_S5RE_P = O_WKV_P + (size_t)NB * NH * HN * HN;
constexpr size_t O_S5IM_P = O_S5RE_P + (size_t)NB * SG * SP;
constexpr size_t O_SHIFT_S = O_S5IM_P + (size_t)NB * SG * SP;
constexpr size_t O_WKV_S = O_SHIFT_S + (size_t)NS * SHIFT;
constexpr size_t O_S5RE_S = O_WKV_S + (size_t)NS * NH * HN * HN;
constexpr size_t O_S5IM_S = O_S5RE_S + (size_t)NS * SG * SP;
constexpr size_t O_END = O_S5IM_S + (size_t)NS * SG * SP;
static_assert(O_END == 22148096, "d_out size");

constexpr size_t MiB = 1u << 20;
constexpr size_t WS_XN = 33 * MiB;
constexpr size_t WS_PR = 66 * MiB;
constexpr size_t WS_U = 119 * MiB;
constexpr size_t WS_GATES = 136 * MiB;
constexpr size_t WS_OA = 217 * MiB;
constexpr size_t WS_HGL = 234 * MiB;
constexpr size_t WS_MERGED = WS_XN;
constexpr size_t WS_MIX = WS_PR;
constexpr size_t WS_H2 = WS_XN;
constexpr size_t WS_HFF = WS_PR;
constexpr size_t WS_F = 156 * MiB;

struct P {
    const float* in[39];
    float* out;
    unsigned char* ws;
    int ph_lo, ph_hi;
};
constexpr int NWAVES = 8, NTHR = NWAVES * 64;
constexpr int LDS_BYTES = 147456, MISC_OFF = 131072 + 320;
#define LAS __attribute__((address_space(3)))
constexpr size_t WS_CTL = 0, CTL_ZERO_BYTES = 1 * MiB;
constexpr int CW_BAR = 4096;

__device__ __forceinline__ const float* xrow(const P& p, int r) { return r < MP ? p.in[0] + (size_t)r * D : p.in[1] + (size_t)(r - MP) * D; }


#define XB_TMO      128
#define XB_XCNT(j)  (256  + 64 * (j))
#define XB_XSUB(j)  (1280 + 64 * (j))
#define XB_XGEN(j)  (2304 + 64 * (j))
#define XB_TOP      3328
#define XB_TOPGEN   3392
#define XCD_BAR_WORDS 3456
#define XB_SPIN_CAP (1u << 18)
__device__ __forceinline__ unsigned xb_ld(unsigned* p)              { return __hip_atomic_load(p, __ATOMIC_RELAXED, __HIP_MEMORY_SCOPE_AGENT); }
__device__ __forceinline__ unsigned xb_add(unsigned* p, unsigned v) { return __hip_atomic_fetch_add(p, v, __ATOMIC_RELAXED, __HIP_MEMORY_SCOPE_AGENT); }
__device__ __forceinline__ unsigned xb_xcc_id() { return (unsigned)__builtin_amdgcn_s_getreg((3 << 11) | 20) & 0xFu; }
#define XB_SPIN(cond, bar) do { unsigned _sp = 0; while (cond) { __builtin_amdgcn_s_sleep(1); \
    if ((++_sp & 255u) == 0u) { if (xb_ld(&(bar)[XB_TMO])) break; if (_sp > XB_SPIN_CAP) { atomicAdd(&(bar)[XB_TMO], 1u); break; } } } } while (0)
struct XcdBarrier { unsigned* bar; unsigned x; volatile LAS unsigned* st; };
__device__ __forceinline__ XcdBarrier xcd_barrier_post(unsigned* bar, volatile LAS unsigned* st) {
    XcdBarrier b; b.bar = bar; b.x = xb_xcc_id(); b.st = st;
    if (threadIdx.x == 0) (void)xb_add(&bar[XB_XCNT(b.x)], 1u);
    return b;
}
__device__ __forceinline__ void xcd_barrier_complete(unsigned* bar, unsigned x, unsigned& nloc, unsigned& nx) {
    const unsigned G = gridDim.x * gridDim.y * gridDim.z;
    unsigned sum, cnt, mine, sp = 0u;
    for (;;) {
        sum = 0u; cnt = 0u; mine = 0u;
#pragma unroll
        for (unsigned j = 0; j < 16; ++j) { const unsigned c = xb_ld(&bar[XB_XCNT(j)]); sum += c; cnt += (c > 0u) ? 1u : 0u; mine = (j == x) ? c : mine; }
        if (sum == G) break;
        __builtin_amdgcn_s_sleep(1);
        if ((++sp & 255u) == 0u) { if (xb_ld(&bar[XB_TMO])) break; if (sp > XB_SPIN_CAP) { atomicAdd(&bar[XB_TMO], 1u); break; } }
    }
    nloc = mine > 0u ? mine : 1u; nx = cnt > 0u ? cnt : 1u;
}
__device__ __forceinline__ void xcd_barrier(const XcdBarrier& b) {
    asm volatile("s_waitcnt vmcnt(0)" ::: "memory");
    __syncthreads();
    if (threadIdx.x == 0) {
        unsigned* bar = b.bar;
        __builtin_amdgcn_s_waitcnt(0);
        unsigned nloc = b.st[0], nx = b.st[1];
        if (nloc == 0u) { xcd_barrier_complete(bar, b.x, nloc, nx); b.st[0] = nloc; b.st[1] = nx; }
        const unsigned old = xb_add(&bar[XB_XSUB(b.x)], 1u);
        const unsigned gen = old / nloc;
        if (old + 1u == (gen + 1u) * nloc) {
            __builtin_amdgcn_fence(__ATOMIC_RELEASE, "agent");
            asm volatile("s_waitcnt vmcnt(0)" ::: "memory");
            const unsigned og = xb_add(&bar[XB_TOP], 1u);
            const unsigned tg = og / nx;
            if (og + 1u == (tg + 1u) * nx) xb_add(&bar[XB_TOPGEN], 1u);
            else XB_SPIN(xb_ld(&bar[XB_TOPGEN]) == tg, bar);
            __builtin_amdgcn_fence(__ATOMIC_ACQUIRE, "agent");
            xb_add(&bar[XB_XGEN(b.x)], 1u);
            asm volatile("s_waitcnt vmcnt(0)" ::: "memory");
        } else {
            XB_SPIN(xb_ld(&bar[XB_XGEN(b.x)]) == gen, bar);
            __builtin_amdgcn_fence(__ATOMIC_ACQUIRE, "agent");
            asm volatile("s_waitcnt vmcnt(0)" ::: "memory");
        }
    }
    __syncthreads();
}

__device__ __forceinline__ void ph_xnorm(const P& p) {
    const int lane = threadIdx.x & 63, gw = blockIdx.x * NWAVES + (threadIdx.x >> 6), NGW = gridDim.x * NWAVES;
    const float* g = p.in[6];
    bf16* xn = (bf16*)(p.ws + WS_XN);
    for (int r = gw; r < M; r += NGW) {
        const float* x = xrow(p, r);
        float v[16]; float s = 0.f;
#pragma unroll
        for (int j = 0; j < 16; ++j) { v[j] = x[lane + 64 * j]; s += v[j] * v[j]; }
        s = wave_sum(s);
        const float rs = rsqrtf(s * (1.f / D) + NORM_EPS);
#pragma unroll
        for (int j = 0; j < 16; ++j) xn[(size_t)r * D + lane + 64 * j] = f2bf(v[j] * rs * g[lane + 64 * j]);
    }
}

template <int NW> struct GemmArgs { const bf16* A[NW]; const float* W[NW]; int lda[NW]; int K[NW]; int Mrows, N; };
template <int NW, class Epi>
__device__ __forceinline__ void ph_gemm(const GemmArgs<NW>& g, const Epi& epi, LAS unsigned char* lds) {
    LAS float (*As)[68] = (LAS float (*)[68])lds;
    LAS float (*Ws)[128] = (LAS float (*)[128])(lds + 16 * 68 * 4);
    const int tid = threadIdx.x, tx = tid & 31, ty = tid >> 5;
    const int ntm = (g.Mrows + 63) / 64, ntn = (g.N + 127) / 128;
    for (int t = blockIdx.x; t < ntm * ntn; t += gridDim.x) {
        const int tm = t / ntn, tn = t % ntn;
        float acc[NW][4][4];
#pragma unroll
        for (int w = 0; w < NW; ++w)
#pragma unroll
            for (int i = 0; i < 4; ++i)
#pragma unroll
                for (int j = 0; j < 4; ++j) acc[w][i][j] = 0.f;
#pragma unroll
        for (int w = 0; w < NW; ++w) {
            for (int k0 = 0; k0 < g.K[w]; k0 += 16) {
                __syncthreads();
#pragma unroll
                for (int i = 0; i < 2; ++i) { const int e = tid + 512 * i, r = e >> 4, k = e & 15; const int row = tm * 64 + r;
                    As[k][r] = row < g.Mrows ? bf2f(g.A[w][(size_t)row * g.lda[w] + k0 + k]) : 0.f; }
#pragma unroll
                for (int i = 0; i < 4; ++i) { const int e = tid + 512 * i, k = e >> 7, c = e & 127; const int col = tn * 128 + c;
                    Ws[k][c] = col < g.N ? g.W[w][(size_t)(k0 + k) * g.N + col] : 0.f; }
                __syncthreads();
#pragma unroll
                for (int k = 0; k < 16; ++k) {
                    float a[4], b[4];
#pragma unroll
                    for (int i = 0; i < 4; ++i) a[i] = As[k][ty * 4 + i];
#pragma unroll
                    for (int j = 0; j < 4; ++j) b[j] = Ws[k][tx * 4 + j];
#pragma unroll
                    for (int i = 0; i < 4; ++i)
#pragma unroll
                        for (int j = 0; j < 4; ++j) acc[w][i][j] += a[i] * b[j];
                }
            }
        }
#pragma unroll
        for (int i = 0; i < 4; ++i)
#pragma unroll
            for (int j = 0; j < 4; ++j) {
                const int row = tm * 64 + ty * 4 + i, col = tn * 128 + tx * 4 + j;
                if (row < g.Mrows && col < g.N) {
                    if constexpr (NW == 1) epi(row, col, acc[0][i][j], 0.f, 0.f);
                    else if constexpr (NW == 2) epi(row, col, acc[0][i][j], acc[1][i][j], 0.f);
                    else epi(row, col, acc[0][i][j], acc[1][i][j], acc[2][i][j]);
                }
            }
    }
    __syncthreads();
}
struct EpiProj {
    bf16 *pr, *u, *gates; float* out;
    __device__ void operator()(int row, int col, float x, float, float) const {
        if (col < SHIFT) {
            pr[(size_t)row * SHIFT + col] = f2bf(x);
            if (row < MP) { if ((row % T) == T - 1) out[O_SHIFT_P + (size_t)(row / T) * SHIFT + col] = x; }
            else out[O_SHIFT_S + (size_t)(row - MP) * SHIFT + col] = x;
        } else if (col < SHIFT + 512) u[(size_t)row * 512 + (col - SHIFT)] = f2bf(x);
        else gates[(size_t)row * 2048 + (col - SHIFT - 512)] = f2bf(sigmoidf_(x));
    }
};
struct EpiMerge {
    const bf16* gates; const float *b1, *b2; bf16* merged;
    __device__ void operator()(int row, int col, float v0, float v1, float v2) const {
        const float ga = bf2f(gates[(size_t)row * 2048 + col]), gb = bf2f(gates[(size_t)row * 2048 + 1024 + col]);
        const float glu = (v1 + b1[col]) * sigmoidf_(v2 + b2[col]);
        merged[(size_t)row * D + col] = f2bf(ga * v0 + gb * glu);
    }
};
struct EpiF32 { float* o; int ld; __device__ void operator()(int row, int col, float v0, float, float) const { o[(size_t)row * ld + col] = v0; } };
struct EpiSwiglu { bf16* o; __device__ void operator()(int row, int col, float gt, float up, float) const { o[(size_t)row * FF + col] = f2bf(gt * sigmoidf_(gt) * up); } };

__device__ __forceinline__ void ph_rwkv_item(const P& p, LAS unsigned char* lds, int item) {
    LAS float (*lw)[64] = (LAS float (*)[64])lds;
    const int lane = threadIdx.x & 63, wv = threadIdx.x >> 6;
    const int seq = (item / NH) * NWAVES + wv, h = item % NH;
    const bool prompt = seq < NB;
    const int nT = prompt ? T : 1, row0 = prompt ? seq * T : MP + (seq - NB);
    const int ch = h * HN + lane;
    const bf16* pr = (const bf16*)(p.ws + WS_PR);
    bf16* oa = (bf16*)(p.ws + WS_OA);
    const float* mu = p.in[11];
    __syncthreads();
    if (wv == 0) {
        for (int j = 0; j < 32; ++j) { lw[j][lane] = p.in[13][(size_t)j * RW + ch]; lw[32 + j][lane] = p.in[15][(size_t)j * RW + ch]; }
        for (int j = 0; j < 64; ++j) lw[64 + j][lane] = p.in[16][(size_t)j * RW + ch];
    }
    __syncthreads();
    const float w0 = p.in[12][ch], a0 = p.in[14][ch], kk_w = p.in[17][ch], ka_w = p.in[18][ch], rk_w = p.in[19][ch], lng = p.in[20][ch], lnb = p.in[21][ch];
    const float mu_r = mu[ch], mu_k = mu[RW + ch], mu_v = mu[2 * RW + ch], mu_l1 = mu[3 * RW + lane], mu_l2 = mu[3 * RW + 64 + lane];
    float S[HN];
    float pr_r, pr_k, pr_v, pr_l1, pr_l2;
    if (prompt) {
#pragma unroll
        for (int k = 0; k < HN; ++k) S[k] = 0.f;
        pr_r = pr_k = pr_v = pr_l1 = pr_l2 = 0.f;
    } else {
        const int sb = seq - NB;
        const float* st = p.in[3] + ((size_t)sb * NH + h) * HN * HN + (size_t)lane * HN;
#pragma unroll
        for (int k = 0; k < HN; ++k) S[k] = st[k];
        const float* sh = p.in[2] + (size_t)sb * SHIFT;
        pr_r = sh[ch]; pr_k = sh[RW + ch]; pr_v = sh[2 * RW + ch]; pr_l1 = sh[3 * RW + lane]; pr_l2 = sh[3 * RW + 64 + lane];
    }
    for (int t = 0; t < nT; ++t) {
        const bf16* prow = pr + (size_t)(row0 + t) * SHIFT;
        const float c_r = bf2f(prow[ch]), c_k = bf2f(prow[RW + ch]), c_v = bf2f(prow[2 * RW + ch]), c_l1 = bf2f(prow[3 * RW + lane]), c_l2 = bf2f(prow[3 * RW + 64 + lane]);
        const float r = c_r + (pr_r - c_r) * mu_r, k = c_k + (pr_k - c_k) * mu_k, v = c_v + (pr_v - c_v) * mu_v;
        const float l1 = c_l1 + (pr_l1 - c_l1) * mu_l1, l2 = c_l2 + (pr_l2 - c_l2) * mu_l2;
        pr_r = c_r; pr_k = c_k; pr_v = c_v; pr_l1 = c_l1; pr_l2 = c_l2;
        const float in1 = lane < 32 ? tanhf(l1) : l1;
        const float in2 = sigmoidf_(l2);
        float sw = 0.f, sa_ = 0.f, sg = 0.f;
#pragma unroll 8
        for (int j = 0; j < 32; ++j) { sw += __shfl(in1, j) * lw[j][lane]; sa_ += __shfl(in1, 32 + j) * lw[32 + j][lane]; }
#pragma unroll 8
        for (int j = 0; j < 64; ++j) sg += __shfl(in2, j) * lw[64 + j][lane];
        const float z = -(w0 + sw);
        const float sp = fmaxf(z, 0.f) + log1pf(__expf(-fabsf(z)));
        const float wlog = -sp - 0.5f;
        const float dec = __expf(-__expf(wlog));
        const float a = sigmoidf_(a0 + sa_);
        const float g = sg;
        float kkv = k * kk_w;
        const float nrm = wave_sum(kkv * kkv);
        kkv = kkv * rsqrtf(fmaxf(nrm, 1e-24f));
        const float kp = k * (1.f + (a - 1.f) * ka_w);
        const float bv = kkv * a;
        float sa = 0.f;
#pragma unroll
        for (int kx = 0; kx < HN; ++kx) sa -= S[kx] * __shfl(kkv, kx);
        float o = 0.f;
#pragma unroll
        for (int kx = 0; kx < HN; ++kx) {
            S[kx] = S[kx] * __shfl(dec, kx) + sa * __shfl(bv, kx) + v * __shfl(kp, kx);
            o += S[kx] * __shfl(r, kx);
        }
        const float mean = wave_sum(o) * (1.f / HN);
        const float dlt = o - mean;
        const float var = wave_sum(dlt * dlt) * (1.f / HN);
        float on = dlt * rsqrtf(var + LNX_EPS) * lng + lnb;
        const float bonus = wave_sum(r * kp * rk_w) * v;
        on = (on + bonus) * g;
        oa[(size_t)(row0 + t) * RW + ch] = f2bf(on);
    }
    float* so = prompt ? p.out + O_WKV_P + ((size_t)seq * NH + h) * HN * HN : p.out + O_WKV_S + ((size_t)(seq - NB) * NH + h) * HN * HN;
#pragma unroll
    for (int k = 0; k < HN; ++k) so[(size_t)lane * HN + k] = S[k];
}

__device__ __forceinline__ float gelu_tanh(float x) { const float c = 0.7978845608028654f; return 0.5f * x * (1.f + tanhf(c * (x + 0.044715f * x * x * x))); }
__device__ __forceinline__ void ph_s5_item(const P& p, int item) {
    const int lane = threadIdx.x & 63;
    const int seq = item / SG, g = item % SG;
    const bool prompt = seq < NB;
    const int nT = prompt ? T : 1, row0 = prompt ? seq * T : MP + (seq - NB);
    const bf16* u = (const bf16*)(p.ws + WS_U);
    bf16* hgl = (bf16*)(p.ws + WS_HGL);
    const float lre = p.in[23][g * SP + lane], lim = p.in[24][g * SP + lane], dt = __expf(p.in[25][g]);
    const float mag = __expf(lre * dt), ang = lim * dt;
    const float lbr = mag * cosf(ang), lbi = mag * sinf(ang);
    const float nr = lbr - 1.f, ni = lbi, den = lre * lre + lim * lim;
    const float fre = (nr * lre + ni * lim) / den, fim = (ni * lre - nr * lim) / den;
    float bbr[SC], bbi[SC], cr[SC], ci[SC];
#pragma unroll
    for (int c = 0; c < SC; ++c) {
        const float br = p.in[26][((size_t)g * SP + lane) * SC + c], bi = p.in[27][((size_t)g * SP + lane) * SC + c];
        bbr[c] = fre * br - fim * bi; bbi[c] = fre * bi + fim * br;
        cr[c] = p.in[28][((size_t)g * SC + c) * SP + lane]; ci[c] = p.in[29][((size_t)g * SC + c) * SP + lane];
    }
    const float dsk = lane < SC ? p.in[30][g * SC + lane] : 0.f;
    float xr = 0.f, xi = 0.f;
    if (!prompt) { xr = p.in[4][((size_t)(seq - NB) * SG + g) * SP + lane]; xi = p.in[5][((size_t)(seq - NB) * SG + g) * SP + lane]; }
    for (int t = 0; t < nT; ++t) {
        const float uv = lane < SC ? bf2f(u[(size_t)(row0 + t) * 512 + g * SC + lane]) : 0.f;
        float bur = 0.f, bui = 0.f;
#pragma unroll
        for (int c = 0; c < SC; ++c) { const float uc = __shfl(uv, c); bur += bbr[c] * uc; bui += bbi[c] * uc; }
        const float nxr = lbr * xr - lbi * xi + bur, nxi = lbr * xi + lbi * xr + bui;
        xr = nxr; xi = nxi;
        float y = 0.f;
#pragma unroll
        for (int c = 0; c < SC; ++c) { const float s = wave_sum(cr[c] * xr - ci[c] * xi); if (lane == c) y = s; }
        if (lane < SC) { y += dsk * uv; hgl[(size_t)(row0 + t) * 512 + g * SC + lane] = f2bf(gelu_tanh(y)); }
    }
    float* ore = prompt ? p.out + O_S5RE_P + ((size_t)seq * SG + g) * SP : p.out + O_S5RE_S + ((size_t)(seq - NB) * SG + g) * SP;
    float* oim = prompt ? p.out + O_S5IM_P + ((size_t)seq * SG + g) * SP : p.out + O_S5IM_S + ((size_t)(seq - NB) * SG + g) * SP;
    ore[lane] = xr; oim[lane] = xi;
}

__device__ __forceinline__ void ph_row1(const P& p) {
    const int lane = threadIdx.x & 63, gw = blockIdx.x * NWAVES + (threadIdx.x >> 6), NGW = gridDim.x * NWAVES;
    const float *g1 = p.in[7], *g2 = p.in[8];
    const float* mix = (const float*)(p.ws + WS_MIX);
    bf16* h2 = (bf16*)(p.ws + WS_H2);
    for (int r = gw; r < M; r += NGW) {
        const float* x = xrow(p, r);
        float v[16]; float s = 0.f;
#pragma unroll
        for (int j = 0; j < 16; ++j) { v[j] = mix[(size_t)r * D + lane + 64 * j]; s += v[j] * v[j]; }
        s = wave_sum(s);
        const float rs = rsqrtf(s * (1.f / D) + NORM_EPS);
        float s2 = 0.f;
#pragma unroll
        for (int j = 0; j < 16; ++j) { v[j] = x[lane + 64 * j] + v[j] * rs * g1[lane + 64 * j]; s2 += v[j] * v[j]; }
        s2 = wave_sum(s2);
        const float rs2 = rsqrtf(s2 * (1.f / D) + NORM_EPS);
#pragma unroll
        for (int j = 0; j < 16; ++j) { p.out[(size_t)r * D + lane + 64 * j] = v[j]; h2[(size_t)r * D + lane + 64 * j] = f2bf(v[j] * rs2 * g2[lane + 64 * j]); }
    }
}
__device__ __forceinline__ void ph_row2(const P& p) {
    const int lane = threadIdx.x & 63, gw = blockIdx.x * NWAVES + (threadIdx.x >> 6), NGW = gridDim.x * NWAVES;
    const float* g3 = p.in[9];
    const float* f = (const float*)(p.ws + WS_F);
    for (int r = gw; r < M; r += NGW) {
        float v[16]; float s = 0.f;
#pragma unroll
        for (int j = 0; j < 16; ++j) { v[j] = f[(size_t)r * D + lane + 64 * j]; s += v[j] * v[j]; }
        s = wave_sum(s);
        const float rs = rsqrtf(s * (1.f / D) + NORM_EPS);
#pragma unroll
        for (int j = 0; j < 16; ++j) { const size_t i = (size_t)r * D + lane + 64 * j; p.out[i] = p.out[i] + v[j] * rs * g3[lane + 64 * j]; }
    }
}


constexpr int N_PHASES = 9;
__global__ void __launch_bounds__(NTHR, 2) mk_fwd(P p) {
    extern __shared__ __attribute__((aligned(16))) unsigned char lds_raw[];
    LAS unsigned char* lds = (LAS unsigned char*)lds_raw;
    volatile LAS unsigned* MISC = (volatile LAS unsigned*)(lds + MISC_OFF);
    for (int u = threadIdx.x; u < (LDS_BYTES - 131072) / 4; u += NTHR) ((LAS unsigned*)(lds + 131072))[u] = 0u;
    __syncthreads();
    unsigned* ctl = (unsigned*)(p.ws + WS_CTL);
    XcdBarrier bar = xcd_barrier_post(ctl + CW_BAR, MISC + 8);
    const int lo = p.ph_lo, hi = p.ph_hi;
    unsigned char* ws = p.ws;
#define IN(k) (lo <= (k) && (k) < hi)
#define SEAM(k) do { if (IN(k) && IN((k) + 1)) xcd_barrier(bar); } while (0)
    if (IN(0)) ph_xnorm(p);
    SEAM(0);
    if (IN(1)) { GemmArgs<1> g{}; g.A[0] = (const bf16*)(ws + WS_XN); g.lda[0] = D; g.W[0] = p.in[10]; g.K[0] = D; g.Mrows = M; g.N = PROJ;
        EpiProj e{(bf16*)(ws + WS_PR), (bf16*)(ws + WS_U), (bf16*)(ws + WS_GATES), p.out};
        ph_gemm<1, EpiProj>(g, e, lds); }
    SEAM(1);
    if (IN(2)) {
        for (int item = blockIdx.x; item < ((NB + NS) / NWAVES) * NH; item += gridDim.x) ph_rwkv_item(p, lds, item);
        const int gw = blockIdx.x * NWAVES + (threadIdx.x >> 6), NGW = gridDim.x * NWAVES;
        for (int it = (gw + NGW / 2) % NGW; it < (NB + NS) * SG; it += NGW) ph_s5_item(p, it);
    }
    SEAM(2);
    if (IN(3)) { GemmArgs<3> g{}; g.A[0] = (const bf16*)(ws + WS_OA); g.lda[0] = RW; g.W[0] = p.in[22]; g.K[0] = RW;
        g.A[1] = (const bf16*)(ws + WS_HGL); g.lda[1] = 512; g.W[1] = p.in[31]; g.K[1] = 512;
        g.A[2] = (const bf16*)(ws + WS_HGL); g.lda[2] = 512; g.W[2] = p.in[33]; g.K[2] = 512; g.Mrows = M; g.N = D;
        EpiMerge e{(const bf16*)(ws + WS_GATES), p.in[32], p.in[34], (bf16*)(ws + WS_MERGED)};
        ph_gemm<3, EpiMerge>(g, e, lds); }
    SEAM(3);
    if (IN(4)) { GemmArgs<1> g{}; g.A[0] = (const bf16*)(ws + WS_MERGED); g.lda[0] = D; g.W[0] = p.in[35]; g.K[0] = D; g.Mrows = M; g.N = D;
        EpiF32 e{(float*)(ws + WS_MIX), D};
        ph_gemm<1, EpiF32>(g, e, lds); }
    SEAM(4);
    if (IN(5)) ph_row1(p);
    SEAM(5);
    if (IN(6)) { GemmArgs<2> g{}; g.A[0] = (const bf16*)(ws + WS_H2); g.lda[0] = D; g.W[0] = p.in[36]; g.K[0] = D;
        g.A[1] = (const bf16*)(ws + WS_H2); g.lda[1] = D; g.W[1] = p.in[37]; g.K[1] = D; g.Mrows = M; g.N = FF;
        EpiSwiglu e{(bf16*)(ws + WS_HFF)};
        ph_gemm<2, EpiSwiglu>(g, e, lds); }
    SEAM(6);
    if (IN(7)) { GemmArgs<1> g{}; g.A[0] = (const bf16*)(ws + WS_HFF); g.lda[0] = FF; g.W[0] = p.in[38]; g.K[0] = FF; g.Mrows = M; g.N = D;
        EpiF32 e{(float*)(ws + WS_F), D};
        ph_gemm<1, EpiF32>(g, e, lds); }
    SEAM(7);
    if (IN(8)) ph_row2(p);
#undef IN
#undef SEAM
}

#ifndef MK_N_LAUNCHES
#define MK_N_LAUNCHES 1
#endif
extern "C" void kernel_launch(void* const* d_in, const int* in_sizes, int n_in, void* d_out, int out_size, void* d_ws, size_t ws_size, hipStream_t stream) {
    static int grid = 0;
    if (grid == 0) {
        if (n_in != 39 || out_size != (int)O_END || ws_size < 256 * MiB) { fprintf(stderr, "kernel_launch: unexpected sizes n_in %d out %d ws %zu\n", n_in, out_size, ws_size); grid = -1; return; }
        int dev = 0, cus = 0;
        if (hipGetDevice(&dev) != hipSuccess || hipDeviceGetAttribute(&cus, hipDeviceAttributeMultiprocessorCount, dev) != hipSuccess) { grid = -1; return; }
        if (hipFuncSetAttribute((const void*)mk_fwd, hipFuncAttributeMaxDynamicSharedMemorySize, LDS_BYTES) != hipSuccess) { fprintf(stderr, "kernel_launch: hipFuncSetAttribute failed\n"); grid = -1; return; }
        grid = cus;
    }
    if (grid < 0) return;
    if (hipMemsetAsync((char*)d_ws + WS_CTL, 0, CTL_ZERO_BYTES, stream) != hipSuccess) return;
    P p{};
    for (int i = 0; i < 39; ++i) p.in[i] = (const float*)d_in[i];
    p.out = (float*)d_out; p.ws = (unsigned char*)d_ws;
    if (MK_N_LAUNCHES == 1) { p.ph_lo = 0; p.ph_hi = N_PHASES; hipLaunchKernelGGL(mk_fwd, dim3(grid), dim3(NTHR), LDS_BYTES, stream, p); }
    else for (int k = 0; k < N_PHASES; ++k) { p.ph_lo = k; p.ph_hi = k + 1; hipLaunchKernelGGL(mk_fwd, dim3(grid), dim3(NTHR), LDS_BYTES, stream, p); }
}
```

```cpp
#include <hip/hip_runtime.h>
#include <cstdint>
#include <cstdio>

constexpr int D = 1024, NB = 8, T = 2048, NS = 128;
constexpr int MP = NB * T;
constexpr int M = MP + NS;
constexpr int RW = 512, HN = 64, NH = 8;
constexpr int SHIFT = 1664, PROJ = 4224;
constexpr int SG = 32, SP = 64, SC = 16;
constexpr int FF = 2816;
constexpr float NORM_EPS = 1e-6f, LNX_EPS = 64e-5f;

typedef unsigned short bf16;
__device__ __forceinline__ float bf2f(bf16 v) { return __uint_as_float((unsigned)v << 16); }
__device__ __forceinline__ bf16 f2bf(float f) { unsigned u = __float_as_uint(f); return (bf16)((u + 0x7fffu + ((u >> 16) & 1u)) >> 16); }
__device__ __forceinline__ float wave_sum(float v) {
#pragma unroll
    for (int o = 1; o < 64; o <<= 1) v += __shfl_xor(v, o);
    return v;
}
__device__ __forceinline__ float sigmoidf_(float x) { return 1.f / (1.f + __expf(-x)); }

constexpr size_t O_Y = 0;
constexpr size_t O_SHIFT_P = (size_t)M * D;
constexpr size_t O_WKV_P = O_SHIFT_P + (size_t)NB * SHIFT;
constexpr size_t O_S5RE_P = O_WKV_P + (size_t)NB * NH * HN * HN;
constexpr size_t O_S5IM_P = O_S5RE_P + (size_t)NB * SG * SP;
constexpr size_t O_SHIFT_S = O_S5IM_P + (size_t)NB * SG * SP;
constexpr size_t O_WKV_S = O_SHIFT_S + (size_t)NS * SHIFT;
constexpr size_t O_S5RE_S = O_WKV_S + (size_t)NS * NH * HN * HN;
constexpr size_t O_S5IM_S = O_S5RE_S + (size_t)NS * SG * SP;
constexpr size_t O_END = O_S5IM_S + (size_t)NS * SG * SP;
static_assert(O_END == 22148096, "d_out size");

constexpr size_t MiB = 1u << 20;
constexpr int MPAD = 16640;
constexpr size_t WS_WT_IN = 1 * MiB;
constexpr size_t WS_WT_RO = WS_WT_IN + 4352 * 1024 * 2;
constexpr size_t WS_WT_GLU = WS_WT_RO + 1024 * 512 * 2;
constexpr size_t WS_WT_MO = WS_WT_GLU + 2048 * 512 * 2;
constexpr size_t WS_WT_GU = WS_WT_MO + 1024 * 1024 * 2;
constexpr size_t WS_WT_DN = WS_WT_GU + 5632 * 1024 * 2;
static_assert(WS_WT_DN + 1024 * 2816 * 2 <= 33 * MiB, "weights region");
constexpr size_t WS_XN = 33 * MiB;
constexpr size_t WS_PR = 66 * MiB;
constexpr size_t WS_U = 119 * MiB;
constexpr size_t WS_GATES = 136 * MiB;
constexpr size_t WS_OA = 217 * MiB;
constexpr size_t WS_HGL = 234 * MiB;
constexpr size_t WS_MERGED = WS_XN;
constexpr size_t WS_MIX = WS_PR;
constexpr size_t WS_H2 = WS_XN;
constexpr size_t WS_HFF = WS_PR;
constexpr size_t WS_F = 156 * MiB;

struct P {
    const float* in[39];
    float* out;
    unsigned char* ws;
    int ph_lo, ph_hi;
};
constexpr int NWAVES = 8, NTHR = NWAVES * 64;
constexpr int LDS_BYTES = 147456, MISC_OFF = 131072 + 320;
#define LAS __attribute__((address_space(3)))
constexpr size_t WS_CTL = 0, CTL_ZERO_BYTES = 1 * MiB;
constexpr int CW_BAR = 4096;

__device__ __forceinline__ const float* xrow(const P& p, int r) { return r < MP ? p.in[0] + (size_t)r * D : p.in[1] + (size_t)(r - MP) * D; }


#define XB_TMO      128
#define XB_XCNT(j)  (256  + 64 * (j))
#define XB_XSUB(j)  (1280 + 64 * (j))
#define XB_XGEN(j)  (2304 + 64 * (j))
#define XB_TOP      3328
#define XB_TOPGEN   3392
#define XCD_BAR_WORDS 3456
#define XB_SPIN_CAP (1u << 18)
__device__ __forceinline__ unsigned xb_ld(unsigned* p)              { return __hip_atomic_load(p, __ATOMIC_RELAXED, __HIP_MEMORY_SCOPE_AGENT); }
__device__ __forceinline__ unsigned xb_add(unsigned* p, unsigned v) { return __hip_atomic_fetch_add(p, v, __ATOMIC_RELAXED, __HIP_MEMORY_SCOPE_AGENT); }
__device__ __forceinline__ unsigned xb_xcc_id() { return (unsigned)__builtin_amdgcn_s_getreg((3 << 11) | 20) & 0xFu; }
#define XB_SPIN(cond, bar) do { unsigned _sp = 0; while (cond) { __builtin_amdgcn_s_sleep(1); \
    if ((++_sp & 255u) == 0u) { if (xb_ld(&(bar)[XB_TMO])) break; if (_sp > XB_SPIN_CAP) { atomicAdd(&(bar)[XB_TMO], 1u); break; } } } } while (0)
struct XcdBarrier { unsigned* bar; unsigned x; volatile LAS unsigned* st; };
__device__ __forceinline__ XcdBarrier xcd_barrier_post(unsigned* bar, volatile LAS unsigned* st) {
    XcdBarrier b; b.bar = bar; b.x = xb_xcc_id(); b.st = st;
    if (threadIdx.x == 0) (void)xb_add(&bar[XB_XCNT(b.x)], 1u);
    return b;
}
__device__ __forceinline__ void xcd_barrier_complete(unsigned* bar, unsigned x, unsigned& nloc, unsigned& nx) {
    const unsigned G = gridDim.x * gridDim.y * gridDim.z;
    unsigned sum, cnt, mine, sp = 0u;
    for (;;) {
        sum = 0u; cnt = 0u; mine = 0u;
#pragma unroll
        for (unsigned j = 0; j < 16; ++j) { const unsigned c = xb_ld(&bar[XB_XCNT(j)]); sum += c; cnt += (c > 0u) ? 1u : 0u; mine = (j == x) ? c : mine; }
        if (sum == G) break;
        __builtin_amdgcn_s_sleep(1);
        if ((++sp & 255u) == 0u) { if (xb_ld(&bar[XB_TMO])) break; if (sp > XB_SPIN_CAP) { atomicAdd(&bar[XB_TMO], 1u); break; } }
    }
    nloc = mine > 0u ? mine : 1u; nx = cnt > 0u ? cnt : 1u;
}
__device__ __forceinline__ void xcd_barrier(const XcdBarrier& b) {
    asm volatile("s_waitcnt vmcnt(0)" ::: "memory");
    __syncthreads();
    if (threadIdx.x == 0) {
        unsigned* bar = b.bar;
        __builtin_amdgcn_s_waitcnt(0);
        unsigned nloc = b.st[0], nx = b.st[1];
        if (nloc == 0u) { xcd_barrier_complete(bar, b.x, nloc, nx); b.st[0] = nloc; b.st[1] = nx; }
        const unsigned old = xb_add(&bar[XB_XSUB(b.x)], 1u);
        const unsigned gen = old / nloc;
        if (old + 1u == (gen + 1u) * nloc) {
            __builtin_amdgcn_fence(__ATOMIC_RELEASE, "agent");
            asm volatile("s_waitcnt vmcnt(0)" ::: "memory");
            const unsigned og = xb_add(&bar[XB_TOP], 1u);
            const unsigned tg = og / nx;
            if (og + 1u == (tg + 1u) * nx) xb_add(&bar[XB_TOPGEN], 1u);
            else XB_SPIN(xb_ld(&bar[XB_TOPGEN]) == tg, bar);
            __builtin_amdgcn_fence(__ATOMIC_ACQUIRE, "agent");
            xb_add(&bar[XB_XGEN(b.x)], 1u);
            asm volatile("s_waitcnt vmcnt(0)" ::: "memory");
        } else {
            XB_SPIN(xb_ld(&bar[XB_XGEN(b.x)]) == gen, bar);
            __builtin_amdgcn_fence(__ATOMIC_ACQUIRE, "agent");
            asm volatile("s_waitcnt vmcnt(0)" ::: "memory");
        }
    }
    __syncthreads();
}

namespace pg8 {
#define PG8_LAS __attribute__((address_space(3)))
typedef unsigned short bf16_t;
typedef short bf16x8 __attribute__((ext_vector_type(8)));
typedef float f32x4 __attribute__((ext_vector_type(4)));
typedef unsigned u32x4 __attribute__((ext_vector_type(4)));
constexpr int BM = 256, BK = 64, HALF = 128, HTB = HALF * BK * 2  , STAGE_BYTES = 8 * HTB, NXCD = 8, WGM = 8;

__host__ __device__ __forceinline__ int lds_byte(int r, int c) { const int st = (r >> 4) * 2 + (c >> 5), rr = r & 15, cc = c & 31, ob = rr * 64 + cc * 2; return st * 1024 + (ob ^ (((ob >> 9) & 1) << 5)); }
__host__ __device__ __forceinline__ void stage_rc(int b, int& R, int& C) { const int st = b / 1024, sb = b % 1024, swz = sb ^ (((sb >> 9) & 1) << 5); R = (st >> 1) * 16 + swz / 64; C = (st & 1) * 32 + (swz % 64) / 2; }
__host__ __device__ __forceinline__ int perm32(int rho) { const int n = rho >> 4, i = rho & 15; return 8 * (i >> 2) + 4 * n + (i & 3); }

struct Unit { int pm, pn; };
struct Gemm { const bf16_t* A; const bf16_t* Bt; int M, N, K; };

struct StaticOrder {
    int nM, nN, nwg, G, c;
    __host__ __device__ void init(int M, int N, int G_, int c_) { nM = M / BM; nN = N / BM; nwg = nM * nN; G = G_; c = c_; }
    __host__ __device__ bool next(int i, Unit& u) const {
        const long L = (long)i * G + c; if (L >= nwg) return false;
        int wgid = (int)L; { const int q = nwg / NXCD, r = nwg % NXCD, xcd = wgid % NXCD, off = wgid / NXCD; wgid = (xcd < r ? xcd * (q + 1) : r * (q + 1) + (xcd - r) * q) + off; }
        const int nig = WGM * nN, gid = wgid / nig, fm = gid * WGM, gsz = (nM - fm) < WGM ? (nM - fm) : WGM;
        u.pm = fm + ((wgid % nig) % gsz); u.pn = (wgid % nig) / gsz; return true;
    }
    __device__ __forceinline__ void a_ready(const Unit&) const {}
    __device__ __forceinline__ void done(const Unit&) const {}
};

__device__ __forceinline__ unsigned cvt_pk_bf16(float lo, float hi) { unsigned r; asm volatile("v_cvt_pk_bf16_f32 %0, %1, %2" : "=v"(r) : "v"(lo), "v"(hi)); return r; }
template <class Epi, class Sched, bool ALIGN_EPI = false, bool SP2 = false>
__device__ __forceinline__ void gemm_phase(PG8_LAS unsigned char* lds, const Gemm g, const Sched& S, const Epi& E) {
    const int tid = threadIdx.x, wid = __builtin_amdgcn_readfirstlane(tid >> 6), lane = tid & 63, wr = wid >> 2, wc = wid & 3, fr = lane & 15, fq = lane >> 4;
    const int K = g.K, nt = K / BK;
    unsigned voffA[2], voffB[2];
#pragma unroll
    for (int i = 0; i < 2; ++i) { int R, C; stage_rc(tid * 16 + i * 8192, R, C); const int Rb = Epi::PERM ? ((R & ~31) + perm32(R & 31)) : R;
        voffA[i] = (unsigned)(R * K + C) * 2u; voffB[i] = (unsigned)(Rb * K + C) * 2u; }
    const size_t kstep = (size_t)(BK * 2);
    const size_t hstep = (size_t)HALF * K * 2;
    const size_t tstep = 2 * hstep;
    const unsigned ldsw = (unsigned)wid * 1024u;
    const int aoff = lds_byte(wr * 64 + fr, fq * 8), boff = lds_byte(wc * 32 + fr, fq * 8);
#define PG8_SA(b, h) (((b) * 2 + (h)) * HTB)
#define PG8_SB(b, h) ((4 + (b) * 2 + (h)) * HTB)
#define PG8_STAGE(bufoff, gbase, voff) do { _Pragma("unroll") for (int _i = 0; _i < 2; ++_i) \
        __builtin_amdgcn_global_load_lds((const unsigned*)((const char*)(gbase) + (voff)[_i]), (PG8_LAS unsigned*)(lds + (bufoff) + ldsw + _i * 8192), 16, 0, 0); } while (0)
#define PG8_LDA(dst, b, h) do { _Pragma("unroll") for (int m = 0; m < 4; ++m) _Pragma("unroll") for (int k = 0; k < 2; ++k) dst[m][k] = *(const PG8_LAS bf16x8*)(lds + PG8_SA(b, h) + aoff + m * 2048 + k * 1024); } while (0)
#define PG8_LDB(dst, b, h) do { _Pragma("unroll") for (int n = 0; n < 2; ++n) _Pragma("unroll") for (int k = 0; k < 2; ++k) dst[n][k] = *(const PG8_LAS bf16x8*)(lds + PG8_SB(b, h) + boff + n * 2048 + k * 1024); } while (0)
#define PG8_MMA(ai, bj, At, Bt) do { __builtin_amdgcn_s_setprio(1); _Pragma("unroll") for (int m = 0; m < 4; ++m) _Pragma("unroll") for (int n = 0; n < 2; ++n) _Pragma("unroll") for (int k = 0; k < 2; ++k) \
        acc[ai][bj][m][n] = __builtin_amdgcn_mfma_f32_16x16x32_bf16(Bt[n][k], At[m][k], acc[ai][bj][m][n], 0, 0, 0); __builtin_amdgcn_s_setprio(0); } while (0)
#define PG8_WAIT_V(n) asm volatile("s_waitcnt vmcnt(" #n ")" ::: "memory")
#define PG8_WAIT_L(n) asm volatile("s_waitcnt lgkmcnt(" #n ")" ::: "memory")
#define PG8_BAR __builtin_amdgcn_s_barrier()
#define PG8_SCHED __builtin_amdgcn_sched_barrier(0)
    Unit cur, nxt; int ui = 0;
    if (!S.next(0, cur)) return;
    f32x4 acc[2][2][4][2];
#pragma unroll
    for (int a = 0; a < 2; ++a)
#pragma unroll
        for (int b = 0; b < 2; ++b)
#pragma unroll
            for (int m = 0; m < 4; ++m)
#pragma unroll
                for (int n = 0; n < 2; ++n) acc[a][b][m][n] = (f32x4){0.f, 0.f, 0.f, 0.f};
    bf16x8 At[4][2], B0[2][2], B1[2][2];
    const char* cA = (const char*)g.A + (size_t)cur.pm * tstep; const char* cB = (const char*)g.Bt + (size_t)cur.pn * tstep;
    S.a_ready(cur);
    if constexpr (SP2) {
        PG8_STAGE(PG8_SB(0, 0), cB, voffB); PG8_STAGE(PG8_SB(0, 1), cB + hstep, voffB); PG8_STAGE(PG8_SA(0, 0), cA, voffA); PG8_STAGE(PG8_SA(0, 1), cA + hstep, voffA);
        if (wr == 1) PG8_BAR;
        PG8_WAIT_V(2); PG8_BAR;
        PG8_STAGE(PG8_SB(1, 0), cB + kstep, voffB); PG8_STAGE(PG8_SA(1, 0), cA + kstep, voffA); PG8_STAGE(PG8_SB(1, 1), cB + hstep + kstep, voffB);
        PG8_WAIT_V(6); PG8_BAR;
    } else {
        PG8_STAGE(PG8_SB(0, 0), cB, voffB); PG8_STAGE(PG8_SA(0, 0), cA, voffA); PG8_STAGE(PG8_SB(0, 1), cB + hstep, voffB); PG8_STAGE(PG8_SA(0, 1), cA + hstep, voffA);
        if (wr == 1) PG8_BAR;
        PG8_WAIT_V(4); PG8_BAR;
        PG8_STAGE(PG8_SB(1, 0), cB + kstep, voffB); PG8_STAGE(PG8_SA(1, 0), cA + kstep, voffA); PG8_STAGE(PG8_SB(1, 1), cB + hstep + kstep, voffB);
        PG8_WAIT_V(6); PG8_BAR;
    }
    for (;;) {
        const bool has_next = S.next(ui + 1, nxt);
        const char* nA = has_next ? (const char*)g.A + (size_t)nxt.pm * tstep : cA; const char* nB = has_next ? (const char*)g.Bt + (size_t)nxt.pn * tstep : cB;
        for (int t = 0; t < nt; t += 2) {
            const bool last = (t == nt - 2);
            const char* a1 = cA + (size_t)(t + 1) * kstep;
            const char* a2 = last ? nA : cA + (size_t)(t + 2) * kstep; const char* b2 = last ? nB : cB + (size_t)(t + 2) * kstep;
            const char* a3 = a2 + kstep; const char* b3 = b2 + kstep;
            if (last && has_next) S.a_ready(nxt);
            if constexpr (SP2) {
            PG8_LDB(B0, 0, 0); PG8_LDB(B1, 0, 1); PG8_SCHED; PG8_LDA(At, 0, 0); PG8_STAGE(PG8_SA(1, 1), a1 + hstep, voffA);
            PG8_WAIT_V(8); PG8_WAIT_L(0); PG8_BAR; PG8_MMA(0, 0, At, B0); PG8_MMA(0, 1, At, B1); PG8_BAR; PG8_SCHED;
            PG8_LDA(At, 0, 1); PG8_STAGE(PG8_SB(0, 0), b2, voffB); PG8_STAGE(PG8_SB(0, 1), b2 + hstep, voffB); PG8_STAGE(PG8_SA(0, 0), a2, voffA);
            PG8_WAIT_V(8); PG8_WAIT_L(0); PG8_BAR; PG8_MMA(1, 0, At, B0); PG8_MMA(1, 1, At, B1); PG8_BAR; PG8_SCHED;
            PG8_LDB(B0, 1, 0); PG8_LDB(B1, 1, 1); PG8_SCHED; PG8_LDA(At, 1, 0); PG8_STAGE(PG8_SA(0, 1), a2 + hstep, voffA);
            PG8_WAIT_V(8); PG8_WAIT_L(0); PG8_BAR; PG8_MMA(0, 0, At, B0); PG8_MMA(0, 1, At, B1); PG8_BAR; PG8_SCHED;
            PG8_LDA(At, 1, 1); PG8_STAGE(PG8_SB(1, 0), b3, voffB); PG8_STAGE(PG8_SB(1, 1), b3 + hstep, voffB); PG8_STAGE(PG8_SA(1, 0), a3, voffA);
            PG8_WAIT_V(8); PG8_WAIT_L(0); PG8_BAR; PG8_MMA(1, 0, At, B0); PG8_MMA(1, 1, At, B1); PG8_BAR; PG8_SCHED;
            } else {
            PG8_LDB(B0, 0, 0); PG8_SCHED; PG8_LDA(At, 0, 0); PG8_STAGE(PG8_SA(1, 1), a1 + hstep, voffA);
            PG8_WAIT_L(8); PG8_BAR; PG8_WAIT_L(0); PG8_MMA(0, 0, At, B0); PG8_BAR; PG8_SCHED;
            PG8_LDB(B1, 0, 1); PG8_STAGE(PG8_SB(0, 0), b2, voffB);
            PG8_BAR; PG8_WAIT_L(0); PG8_MMA(0, 1, At, B1); PG8_BAR;
            PG8_LDA(At, 0, 1); PG8_STAGE(PG8_SA(0, 0), a2, voffA);
            PG8_BAR; PG8_WAIT_L(0); PG8_MMA(1, 0, At, B0); PG8_BAR; PG8_SCHED;
            PG8_STAGE(PG8_SB(0, 1), b2 + hstep, voffB);
            PG8_WAIT_V(6); PG8_BAR; PG8_MMA(1, 1, At, B1); PG8_BAR;
            PG8_LDB(B0, 1, 0); PG8_SCHED; PG8_LDA(At, 1, 0); PG8_STAGE(PG8_SA(0, 1), a2 + hstep, voffA);
            PG8_WAIT_L(8); PG8_BAR; PG8_WAIT_L(0); PG8_MMA(0, 0, At, B0); PG8_BAR; PG8_SCHED;
            PG8_LDB(B1, 1, 1); PG8_STAGE(PG8_SB(1, 0), b3, voffB);
            PG8_BAR; PG8_WAIT_L(0); PG8_MMA(0, 1, At, B1); PG8_BAR;
            PG8_LDA(At, 1, 1); PG8_STAGE(PG8_SA(1, 0), a3, voffA);
            PG8_BAR; PG8_WAIT_L(0); PG8_MMA(1, 0, At, B0); PG8_BAR; PG8_SCHED;
            PG8_STAGE(PG8_SB(1, 1), b3 + hstep, voffB);
            PG8_WAIT_V(6); PG8_BAR; PG8_MMA(1, 1, At, B1); PG8_BAR;
            }
        }
        if constexpr (ALIGN_EPI) { if (wr == 0) PG8_BAR; }
        if constexpr (!Epi::AFTER_DRAIN) { E(acc, cur, wr, wc, fr, fq); S.done(cur); }
        if (!has_next) break;
#pragma unroll
        for (int a = 0; a < 2; ++a)
#pragma unroll
            for (int b = 0; b < 2; ++b)
#pragma unroll
                for (int m = 0; m < 4; ++m)
#pragma unroll
                    for (int n = 0; n < 2; ++n) acc[a][b][m][n] = (f32x4){0.f, 0.f, 0.f, 0.f};
        cur = nxt; cA = nA; cB = nB; ++ui;
        if constexpr (ALIGN_EPI) { if (wr == 1) PG8_BAR; }
    }
    PG8_WAIT_V(0);
    if constexpr (!ALIGN_EPI) { if (wr == 0) PG8_BAR; }
    PG8_BAR;
    if constexpr (Epi::AFTER_DRAIN) { E.fused(acc, cur, wr, wc, fr, fq, lds, wid, lane); S.done(cur); }
#undef PG8_SA
#undef PG8_SB
#undef PG8_STAGE
#undef PG8_LDA
#undef PG8_LDB
#undef PG8_MMA
#undef PG8_WAIT_V
#undef PG8_WAIT_L
#undef PG8_BAR
#undef PG8_SCHED
}
}

typedef pg8::f32x4 f32x4;
typedef pg8::u32x4 u32x4;
__device__ __forceinline__ u32x4 pack8(const f32x4& a, const f32x4& b) { u32x4 w; w.x = pg8::cvt_pk_bf16(a[0], a[1]); w.y = pg8::cvt_pk_bf16(a[2], a[3]); w.z = pg8::cvt_pk_bf16(b[0], b[1]); w.w = pg8::cvt_pk_bf16(b[2], b[3]); return w; }
__device__ __forceinline__ void unpack8(const u32x4& w, f32x4& a, f32x4& b) {
    a[0] = __uint_as_float(w.x << 16); a[1] = __uint_as_float(w.x & 0xffff0000u); a[2] = __uint_as_float(w.y << 16); a[3] = __uint_as_float(w.y & 0xffff0000u);
    b[0] = __uint_as_float(w.z << 16); b[1] = __uint_as_float(w.z & 0xffff0000u); b[2] = __uint_as_float(w.w << 16); b[3] = __uint_as_float(w.w & 0xffff0000u); }
__device__ __forceinline__ f32x4 sig4(const f32x4& v) { f32x4 r; r[0] = sigmoidf_(v[0]); r[1] = sigmoidf_(v[1]); r[2] = sigmoidf_(v[2]); r[3] = sigmoidf_(v[3]); return r; }

struct EpiProjM {
    static constexpr bool PERM = true, AFTER_DRAIN = false;
    bf16 *pr, *u, *gates; float* out;
    __device__ __forceinline__ void operator()(const f32x4 (&acc)[2][2][4][2], const pg8::Unit& un, int wr, int wc, int fr, int fq) const {
#pragma unroll
        for (int bj = 0; bj < 2; ++bj) {
            const int col = un.pn * 256 + bj * 128 + wc * 32 + 8 * fq;
            if (col >= PROJ) continue;
#pragma unroll
            for (int ai = 0; ai < 2; ++ai)
#pragma unroll
                for (int m = 0; m < 4; ++m) {
                    const int row = un.pm * 256 + ai * 128 + wr * 64 + m * 16 + fr;
                    const f32x4 v0 = acc[ai][bj][m][0], v1 = acc[ai][bj][m][1];
                    if (col < SHIFT) {
                        *(u32x4*)(pr + (size_t)row * SHIFT + col) = pack8(v0, v1);
                        float* o = nullptr;
                        if (row < MP) { if ((row & (T - 1)) == T - 1) o = out + O_SHIFT_P + (size_t)(row / T) * SHIFT + col; }
                        else if (row < M) o = out + O_SHIFT_S + (size_t)(row - MP) * SHIFT + col;
                        if (o) { *(f32x4*)o = v0; *(f32x4*)(o + 4) = v1; }
                    } else if (col < SHIFT + 512) *(u32x4*)(u + (size_t)row * 512 + (col - SHIFT)) = pack8(v0, v1);
                    else *(u32x4*)(gates + (size_t)row * 2048 + (col - SHIFT - 512)) = pack8(sig4(v0), sig4(v1));
                }
        }
    }
};
struct EpiA1M {
    static constexpr bool PERM = true, AFTER_DRAIN = false;
    const bf16* gates; bf16* merged;
    __device__ __forceinline__ void operator()(const f32x4 (&acc)[2][2][4][2], const pg8::Unit& un, int wr, int wc, int fr, int fq) const {
#pragma unroll
        for (int ai = 0; ai < 2; ++ai)
#pragma unroll
            for (int m = 0; m < 4; ++m) {
                const int row = un.pm * 256 + ai * 128 + wr * 64 + m * 16 + fr;
#pragma unroll
                for (int bj = 0; bj < 2; ++bj) {
                    const int col = un.pn * 256 + bj * 128 + wc * 32 + 8 * fq;
                    f32x4 g0, g1; unpack8(*(const u32x4*)(gates + (size_t)row * 2048 + col), g0, g1);
                    *(u32x4*)(merged + (size_t)row * D + col) = pack8(acc[ai][bj][m][0] * g0, acc[ai][bj][m][1] * g1);
                }
            }
    }
};
struct EpiGluM {
    static constexpr bool PERM = true, AFTER_DRAIN = false;
    const bf16* gates; const float *b1, *b2; bf16* merged;
    __device__ __forceinline__ void operator()(const f32x4 (&acc)[2][2][4][2], const pg8::Unit& un, int wr, int wc, int fr, int fq) const {
        const int col = un.pn * 128 + wc * 32 + 8 * fq;
        const f32x4 b1a = *(const f32x4*)(b1 + col), b1b = *(const f32x4*)(b1 + col + 4), b2a = *(const f32x4*)(b2 + col), b2b = *(const f32x4*)(b2 + col + 4);
#pragma unroll
        for (int ai = 0; ai < 2; ++ai)
#pragma unroll
            for (int m = 0; m < 4; ++m) {
                const int row = un.pm * 256 + ai * 128 + wr * 64 + m * 16 + fr;
                f32x4 g0, g1, t0, t1; unpack8(*(const u32x4*)(gates + (size_t)row * 2048 + 1024 + col), g0, g1); unpack8(*(const u32x4*)(merged + (size_t)row * D + col), t0, t1);
                const f32x4 o0 = t0 + g0 * ((acc[ai][0][m][0] + b1a) * sig4(acc[ai][1][m][0] + b2a));
                const f32x4 o1 = t1 + g1 * ((acc[ai][0][m][1] + b1b) * sig4(acc[ai][1][m][1] + b2b));
                *(u32x4*)(merged + (size_t)row * D + col) = pack8(o0, o1);
            }
    }
};
struct EpiF32M {
    static constexpr bool PERM = false, AFTER_DRAIN = false;
    float* o; int ld;
    __device__ __forceinline__ void operator()(const f32x4 (&acc)[2][2][4][2], const pg8::Unit& un, int wr, int wc, int fr, int fq) const {
#pragma unroll
        for (int ai = 0; ai < 2; ++ai)
#pragma unroll
            for (int m = 0; m < 4; ++m) {
                const int row = un.pm * 256 + ai * 128 + wr * 64 + m * 16 + fr;
#pragma unroll
                for (int bj = 0; bj < 2; ++bj)
#pragma unroll
                    for (int n = 0; n < 2; ++n) *(f32x4*)(o + (size_t)row * ld + un.pn * 256 + bj * 128 + wc * 32 + 16 * n + 4 * fq) = acc[ai][bj][m][n];
            }
    }
};
struct EpiSwigluM {
    static constexpr bool PERM = true, AFTER_DRAIN = false;
    bf16* o;
    __device__ __forceinline__ void operator()(const f32x4 (&acc)[2][2][4][2], const pg8::Unit& un, int wr, int wc, int fr, int fq) const {
        const int col = un.pn * 128 + wc * 32 + 8 * fq;
#pragma unroll
        for (int ai = 0; ai < 2; ++ai)
#pragma unroll
            for (int m = 0; m < 4; ++m) {
                const int row = un.pm * 256 + ai * 128 + wr * 64 + m * 16 + fr;
                const f32x4 g0 = acc[ai][0][m][0], g1 = acc[ai][0][m][1];
                *(u32x4*)(o + (size_t)row * FF + col) = pack8(g0 * sig4(g0) * acc[ai][1][m][0], g1 * sig4(g1) * acc[ai][1][m][1]);
            }
    }
};

__device__ __forceinline__ void tr_item(const float* W, int K, int N, bf16* WT, int k0, int n0, int drow0, LAS float* scr, int lane) {
#pragma unroll 8
    for (int i = 0; i < 32; ++i) { const int kk = 2 * i + (lane >> 5); scr[kk * 33 + (lane & 31)] = W[(size_t)(k0 + kk) * N + n0 + (lane & 31)]; }
    asm volatile("s_waitcnt lgkmcnt(0)" ::: "memory");
    const int c = lane & 7;
#pragma unroll
    for (int j = 0; j < 4; ++j) { const int n = (lane >> 3) + 8 * j; const LAS float* s = scr + (8 * c) * 33 + n;
        u32x4 o; o.x = pg8::cvt_pk_bf16(s[0 * 33], s[1 * 33]); o.y = pg8::cvt_pk_bf16(s[2 * 33], s[3 * 33]); o.z = pg8::cvt_pk_bf16(s[4 * 33], s[5 * 33]); o.w = pg8::cvt_pk_bf16(s[6 * 33], s[7 * 33]);
        *(u32x4*)(WT + (size_t)(drow0 + n) * K + k0 + 8 * c) = o; }
    asm volatile("s_waitcnt lgkmcnt(0)" ::: "memory");
}
__device__ __forceinline__ bool tr_seg(int& r, const float* W, int K, int N, bf16* WT, int mode, LAS float* scr, int lane) {
    const int nblk = N / 32, items = (K / 64) * nblk;
    if (r >= items) { r -= items; return false; }
    const int kb = r / nblk, nb = r % nblk, n0 = 32 * nb;
    const int drow0 = mode == 0 ? n0 : 256 * (n0 / 128) + 128 * (mode - 1) + (n0 % 128);
    tr_item(W, K, N, WT, 64 * kb, n0, drow0, scr, lane);
    return true;
}
__device__ __forceinline__ void ph_prologue(const P& p, LAS unsigned char* lds) {
    const int lane = threadIdx.x & 63, wv = threadIdx.x >> 6, gw = blockIdx.x * NWAVES + wv, NGW = gridDim.x * NWAVES;
    LAS float* scr = (LAS float*)(lds + wv * 16384);
    unsigned char* ws = p.ws;
    constexpr int NITEMS = 16 * 132 + 8 * 32 * 3 + 16 * 32 + 16 * 88 * 2 + 44 * 32;
    for (int it = gw; it < NITEMS; it += NGW) {
        int r = it;
        if (tr_seg(r, p.in[10], 1024, PROJ, (bf16*)(ws + WS_WT_IN), 0, scr, lane)) continue;
        if (tr_seg(r, p.in[22], 512, 1024, (bf16*)(ws + WS_WT_RO), 0, scr, lane)) continue;
        if (tr_seg(r, p.in[31], 512, 1024, (bf16*)(ws + WS_WT_GLU), 1, scr, lane)) continue;
        if (tr_seg(r, p.in[33], 512, 1024, (bf16*)(ws + WS_WT_GLU), 2, scr, lane)) continue;
        if (tr_seg(r, p.in[35], 1024, 1024, (bf16*)(ws + WS_WT_MO), 0, scr, lane)) continue;
        if (tr_seg(r, p.in[36], 1024, FF, (bf16*)(ws + WS_WT_GU), 1, scr, lane)) continue;
        if (tr_seg(r, p.in[37], 1024, FF, (bf16*)(ws + WS_WT_GU), 2, scr, lane)) continue;
        tr_seg(r, p.in[38], FF, 1024, (bf16*)(ws + WS_WT_DN), 0, scr, lane);
    }
}
template <class Epi>
__device__ __forceinline__ void ph_mfma_gemm(LAS unsigned char* lds, const bf16* A, const bf16* Bt, int N, int K, const Epi& e) {
    pg8::Gemm g{A, Bt, MPAD, N, K}; pg8::StaticOrder S; S.init(MPAD, N, (int)gridDim.x, (int)blockIdx.x);
    pg8::gemm_phase<Epi, pg8::StaticOrder, true, true>(lds, g, S, e);
}

__device__ __forceinline__ void ph_xnorm(const P& p) {
    const int lane = threadIdx.x & 63, gw = blockIdx.x * NWAVES + (threadIdx.x >> 6), NGW = gridDim.x * NWAVES;
    const float* g = p.in[6];
    bf16* xn = (bf16*)(p.ws + WS_XN);
    for (int r = gw; r < M; r += NGW) {
        const float* x = xrow(p, r);
        float v[16]; float s = 0.f;
#pragma unroll
        for (int j = 0; j < 16; ++j) { v[j] = x[lane + 64 * j]; s += v[j] * v[j]; }
        s = wave_sum(s);
        const float rs = rsqrtf(s * (1.f / D) + NORM_EPS);
#pragma unroll
        for (int j = 0; j < 16; ++j) xn[(size_t)r * D + lane + 64 * j] = f2bf(v[j] * rs * g[lane + 64 * j]);
    }
}

template <int NW> struct GemmArgs { const bf16* A[NW]; const float* W[NW]; int lda[NW]; int K[NW]; int Mrows, N; };
template <int NW, class Epi>
__device__ __forceinline__ void ph_gemm(const GemmArgs<NW>& g, const Epi& epi, LAS unsigned char* lds) {
    LAS float (*As)[68] = (LAS float (*)[68])lds;
    LAS float (*Ws)[128] = (LAS float (*)[128])(lds + 16 * 68 * 4);
    const int tid = threadIdx.x, tx = tid & 31, ty = tid >> 5;
    const int ntm = (g.Mrows + 63) / 64, ntn = (g.N + 127) / 128;
    for (int t = blockIdx.x; t < ntm * ntn; t += gridDim.x) {
        const int tm = t / ntn, tn = t % ntn;
        float acc[NW][4][4];
#pragma unroll
        for (int w = 0; w < NW; ++w)
#pragma unroll
            for (int i = 0; i < 4; ++i)
#pragma unroll
                for (int j = 0; j < 4; ++j) acc[w][i][j] = 0.f;
#pragma unroll
        for (int w = 0; w < NW; ++w) {
            for (int k0 = 0; k0 < g.K[w]; k0 += 16) {
                __syncthreads();
#pragma unroll
                for (int i = 0; i < 2; ++i) { const int e = tid + 512 * i, r = e >> 4, k = e & 15; const int row = tm * 64 + r;
                    As[k][r] = row < g.Mrows ? bf2f(g.A[w][(size_t)row * g.lda[w] + k0 + k]) : 0.f; }
#pragma unroll
                for (int i = 0; i < 4; ++i) { const int e = tid + 512 * i, k = e >> 7, c = e & 127; const int col = tn * 128 + c;
                    Ws[k][c] = col < g.N ? g.W[w][(size_t)(k0 + k) * g.N + col] : 0.f; }
                __syncthreads();
#pragma unroll
                for (int k = 0; k < 16; ++k) {
                    float a[4], b[4];
#pragma unroll
                    for (int i = 0; i < 4; ++i) a[i] = As[k][ty * 4 + i];
#pragma unroll
                    for (int j = 0; j < 4; ++j) b[j] = Ws[k][tx * 4 + j];
#pragma unroll
                    for (int i = 0; i < 4; ++i)
#pragma unroll
                        for (int j = 0; j < 4; ++j) acc[w][i][j] += a[i] * b[j];
                }
            }
        }
#pragma unroll
        for (int i = 0; i < 4; ++i)
#pragma unroll
            for (int j = 0; j < 4; ++j) {
                const int row = tm * 64 + ty * 4 + i, col = tn * 128 + tx * 4 + j;
                if (row < g.Mrows && col < g.N) {
                    if constexpr (NW == 1) epi(row, col, acc[0][i][j], 0.f, 0.f);
                    else if constexpr (NW == 2) epi(row, col, acc[0][i][j], acc[1][i][j], 0.f);
                    else epi(row, col, acc[0][i][j], acc[1][i][j], acc[2][i][j]);
                }
            }
    }
    __syncthreads();
}
struct EpiProj {
    bf16 *pr, *u, *gates; float* out;
    __device__ void operator()(int row, int col, float x, float, float) const {
        if (col < SHIFT) {
            pr[(size_t)row * SHIFT + col] = f2bf(x);
            if (row < MP) { if ((row % T) == T - 1) out[O_SHIFT_P + (size_t)(row / T) * SHIFT + col] = x; }
            else out[O_SHIFT_S + (size_t)(row - MP) * SHIFT + col] = x;
        } else if (col < SHIFT + 512) u[(size_t)row * 512 + (col - SHIFT)] = f2bf(x);
        else gates[(size_t)row * 2048 + (col - SHIFT - 512)] = f2bf(sigmoidf_(x));
    }
};
struct EpiMerge {
    const bf16* gates; const float *b1, *b2; bf16* merged;
    __device__ void operator()(int row, int col, float v0, float v1, float v2) const {
        const float ga = bf2f(gates[(size_t)row * 2048 + col]), gb = bf2f(gates[(size_t)row * 2048 + 1024 + col]);
        const float glu = (v1 + b1[col]) * sigmoidf_(v2 + b2[col]);
        merged[(size_t)row * D + col] = f2bf(ga * v0 + gb * glu);
    }
};
struct EpiF32 { float* o; int ld; __device__ void operator()(int row, int col, float v0, float, float) const { o[(size_t)row * ld + col] = v0; } };
struct EpiSwiglu { bf16* o; __device__ void operator()(int row, int col, float gt, float up, float) const { o[(size_t)row * FF + col] = f2bf(gt * sigmoidf_(gt) * up); } };

__device__ __forceinline__ void ph_rwkv_item(const P& p, LAS unsigned char* lds, int item) {
    LAS float (*lw)[64] = (LAS float (*)[64])lds;
    const int lane = threadIdx.x & 63, wv = threadIdx.x >> 6;
    const int seq = (item / NH) * NWAVES + wv, h = item % NH;
    const bool prompt = seq < NB;
    const int nT = prompt ? T : 1, row0 = prompt ? seq * T : MP + (seq - NB);
    const int ch = h * HN + lane;
    const bf16* pr = (const bf16*)(p.ws + WS_PR);
    bf16* oa = (bf16*)(p.ws + WS_OA);
    const float* mu = p.in[11];
    __syncthreads();
    if (wv == 0) {
        for (int j = 0; j < 32; ++j) { lw[j][lane] = p.in[13][(size_t)j * RW + ch]; lw[32 + j][lane] = p.in[15][(size_t)j * RW + ch]; }
        for (int j = 0; j < 64; ++j) lw[64 + j][lane] = p.in[16][(size_t)j * RW + ch];
    }
    __syncthreads();
    const float w0 = p.in[12][ch], a0 = p.in[14][ch], kk_w = p.in[17][ch], ka_w = p.in[18][ch], rk_w = p.in[19][ch], lng = p.in[20][ch], lnb = p.in[21][ch];
    const float mu_r = mu[ch], mu_k = mu[RW + ch], mu_v = mu[2 * RW + ch], mu_l1 = mu[3 * RW + lane], mu_l2 = mu[3 * RW + 64 + lane];
    float S[HN];
    float pr_r, pr_k, pr_v, pr_l1, pr_l2;
    if (prompt) {
#pragma unroll
        for (int k = 0; k < HN; ++k) S[k] = 0.f;
        pr_r = pr_k = pr_v = pr_l1 = pr_l2 = 0.f;
    } else {
        const int sb = seq - NB;
        const float* st = p.in[3] + ((size_t)sb * NH + h) * HN * HN + (size_t)lane * HN;
#pragma unroll
        for (int k = 0; k < HN; ++k) S[k] = st[k];
        const float* sh = p.in[2] + (size_t)sb * SHIFT;
        pr_r = sh[ch]; pr_k = sh[RW + ch]; pr_v = sh[2 * RW + ch]; pr_l1 = sh[3 * RW + lane]; pr_l2 = sh[3 * RW + 64 + lane];
    }
    for (int t = 0; t < nT; ++t) {
        const bf16* prow = pr + (size_t)(row0 + t) * SHIFT;
        const float c_r = bf2f(prow[ch]), c_k = bf2f(prow[RW + ch]), c_v = bf2f(prow[2 * RW + ch]), c_l1 = bf2f(prow[3 * RW + lane]), c_l2 = bf2f(prow[3 * RW + 64 + lane]);
        const float r = c_r + (pr_r - c_r) * mu_r, k = c_k + (pr_k - c_k) * mu_k, v = c_v + (pr_v - c_v) * mu_v;
        const float l1 = c_l1 + (pr_l1 - c_l1) * mu_l1, l2 = c_l2 + (pr_l2 - c_l2) * mu_l2;
        pr_r = c_r; pr_k = c_k; pr_v = c_v; pr_l1 = c_l1; pr_l2 = c_l2;
        const float in1 = lane < 32 ? tanhf(l1) : l1;
        const float in2 = sigmoidf_(l2);
        float sw = 0.f, sa_ = 0.f, sg = 0.f;
#pragma unroll 8
        for (int j = 0; j < 32; ++j) { sw += __shfl(in1, j) * lw[j][lane]; sa_ += __shfl(in1, 32 + j) * lw[32 + j][lane]; }
#pragma unroll 8
        for (int j = 0; j < 64; ++j) sg += __shfl(in2, j) * lw[64 + j][lane];
        const float z = -(w0 + sw);
        const float sp = fmaxf(z, 0.f) + log1pf(__expf(-fabsf(z)));
        const float wlog = -sp - 0.5f;
        const float dec = __expf(-__expf(wlog));
        const float a = sigmoidf_(a0 + sa_);
        const float g = sg;
        float kkv = k * kk_w;
        const float nrm = wave_sum(kkv * kkv);
        kkv = kkv * rsqrtf(fmaxf(nrm, 1e-24f));
        const float kp = k * (1.f + (a - 1.f) * ka_w);
        const float bv = kkv * a;
        float sa = 0.f;
#pragma unroll
        for (int kx = 0; kx < HN; ++kx) sa -= S[kx] * __shfl(kkv, kx);
        float o = 0.f;
#pragma unroll
        for (int kx = 0; kx < HN; ++kx) {
            S[kx] = S[kx] * __shfl(dec, kx) + sa * __shfl(bv, kx) + v * __shfl(kp, kx);
            o += S[kx] * __shfl(r, kx);
        }
        const float mean = wave_sum(o) * (1.f / HN);
        const float dlt = o - mean;
        const float var = wave_sum(dlt * dlt) * (1.f / HN);
        float on = dlt * rsqrtf(var + LNX_EPS) * lng + lnb;
        const float bonus = wave_sum(r * kp * rk_w) * v;
        on = (on + bonus) * g;
        oa[(size_t)(row0 + t) * RW + ch] = f2bf(on);
    }
    float* so = prompt ? p.out + O_WKV_P + ((size_t)seq * NH + h) * HN * HN : p.out + O_WKV_S + ((size_t)(seq - NB) * NH + h) * HN * HN;
#pragma unroll
    for (int k = 0; k < HN; ++k) so[(size_t)lane * HN + k] = S[k];
}

__device__ __forceinline__ float gelu_tanh(float x) { const float c = 0.7978845608028654f; return 0.5f * x * (1.f + tanhf(c * (x + 0.044715f * x * x * x))); }
__device__ __forceinline__ void ph_s5_item(const P& p, int item) {
    const int lane = threadIdx.x & 63;
    const int seq = item / SG, g = item % SG;
    const bool prompt = seq < NB;
    const int nT = prompt ? T : 1, row0 = prompt ? seq * T : MP + (seq - NB);
    const bf16* u = (const bf16*)(p.ws + WS_U);
    bf16* hgl = (bf16*)(p.ws + WS_HGL);
    const float lre = p.in[23][g * SP + lane], lim = p.in[24][g * SP + lane], dt = __expf(p.in[25][g]);
    const float mag = __expf(lre * dt), ang = lim * dt;
    const float lbr = mag * cosf(ang), lbi = mag * sinf(ang);
    const float nr = lbr - 1.f, ni = lbi, den = lre * lre + lim * lim;
    const float fre = (nr * lre + ni * lim) / den, fim = (ni * lre - nr * lim) / den;
    float bbr[SC], bbi[SC], cr[SC], ci[SC];
#pragma unroll
    for (int c = 0; c < SC; ++c) {
        const float br = p.in[26][((size_t)g * SP + lane) * SC + c], bi = p.in[27][((size_t)g * SP + lane) * SC + c];
        bbr[c] = fre * br - fim * bi; bbi[c] = fre * bi + fim * br;
        cr[c] = p.in[28][((size_t)g * SC + c) * SP + lane]; ci[c] = p.in[29][((size_t)g * SC + c) * SP + lane];
    }
    const float dsk = lane < SC ? p.in[30][g * SC + lane] : 0.f;
    float xr = 0.f, xi = 0.f;
    if (!prompt) { xr = p.in[4][((size_t)(seq - NB) * SG + g) * SP + lane]; xi = p.in[5][((size_t)(seq - NB) * SG + g) * SP + lane]; }
    for (int t = 0; t < nT; ++t) {
        const float uv = lane < SC ? bf2f(u[(size_t)(row0 + t) * 512 + g * SC + lane]) : 0.f;
        float bur = 0.f, bui = 0.f;
#pragma unroll
        for (int c = 0; c < SC; ++c) { const float uc = __shfl(uv, c); bur += bbr[c] * uc; bui += bbi[c] * uc; }
        const float nxr = lbr * xr - lbi * xi + bur, nxi = lbr * xi + lbi * xr + bui;
        xr = nxr; xi = nxi;
        float y = 0.f;
#pragma unroll
        for (int c = 0; c < SC; ++c) { const float s = wave_sum(cr[c] * xr - ci[c] * xi); if (lane == c) y = s; }
        if (lane < SC) { y += dsk * uv; hgl[(size_t)(row0 + t) * 512 + g * SC + lane] = f2bf(gelu_tanh(y)); }
    }
    float* ore = prompt ? p.out + O_S5RE_P + ((size_t)seq * SG + g) * SP : p.out + O_S5RE_S + ((size_t)(seq - NB) * SG + g) * SP;
    float* oim = prompt ? p.out + O_S5IM_P + ((size_t)seq * SG + g) * SP : p.out + O_S5IM_S + ((size_t)(seq - NB) * SG + g) * SP;
    ore[lane] = xr; oim[lane] = xi;
}

__device__ __forceinline__ void ph_row1(const P& p) {
    const int lane = threadIdx.x & 63, gw = blockIdx.x * NWAVES + (threadIdx.x >> 6), NGW = gridDim.x * NWAVES;
    const float *g1 = p.in[7], *g2 = p.in[8];
    const float* mix = (const float*)(p.ws + WS_MIX);
    bf16* h2 = (bf16*)(p.ws + WS_H2);
    for (int r = gw; r < M; r += NGW) {
        const float* x = xrow(p, r);
        float v[16]; float s = 0.f;
#pragma unroll
        for (int j = 0; j < 16; ++j) { v[j] = mix[(size_t)r * D + lane + 64 * j]; s += v[j] * v[j]; }
        s = wave_sum(s);
        const float rs = rsqrtf(s * (1.f / D) + NORM_EPS);
        float s2 = 0.f;
#pragma unroll
        for (int j = 0; j < 16; ++j) { v[j] = x[lane + 64 * j] + v[j] * rs * g1[lane + 64 * j]; s2 += v[j] * v[j]; }
        s2 = wave_sum(s2);
        const float rs2 = rsqrtf(s2 * (1.f / D) + NORM_EPS);
#pragma unroll
        for (int j = 0; j < 16; ++j) { p.out[(size_t)r * D + lane + 64 * j] = v[j]; h2[(size_t)r * D + lane + 64 * j] = f2bf(v[j] * rs2 * g2[lane + 64 * j]); }
    }
}
__device__ __forceinline__ void ph_row2(const P& p) {
    const int lane = threadIdx.x & 63, gw = blockIdx.x * NWAVES + (threadIdx.x >> 6), NGW = gridDim.x * NWAVES;
    const float* g3 = p.in[9];
    const float* f = (const float*)(p.ws + WS_F);
    for (int r = gw; r < M; r += NGW) {
        float v[16]; float s = 0.f;
#pragma unroll
        for (int j = 0; j < 16; ++j) { v[j] = f[(size_t)r * D + lane + 64 * j]; s += v[j] * v[j]; }
        s = wave_sum(s);
        const float rs = rsqrtf(s * (1.f / D) + NORM_EPS);
#pragma unroll
        for (int j = 0; j < 16; ++j) { const size_t i = (size_t)r * D + lane + 64 * j; p.out[i] = p.out[i] + v[j] * rs * g3[lane + 64 * j]; }
    }
}


constexpr int N_PHASES = 10;
__global__ void __launch_bounds__(NTHR, 2) mk_fwd(P p) {
    extern __shared__ __attribute__((aligned(16))) unsigned char lds_raw[];
    LAS unsigned char* lds = (LAS unsigned char*)lds_raw;
    volatile LAS unsigned* MISC = (volatile LAS unsigned*)(lds + MISC_OFF);
    for (int u = threadIdx.x; u < (LDS_BYTES - 131072) / 4; u += NTHR) ((LAS unsigned*)(lds + 131072))[u] = 0u;
    __syncthreads();
    unsigned* ctl = (unsigned*)(p.ws + WS_CTL);
    XcdBarrier bar = xcd_barrier_post(ctl + CW_BAR, MISC + 8);
    const int lo = p.ph_lo, hi = p.ph_hi;
    unsigned char* ws = p.ws;
#define IN(k) (lo <= (k) && (k) < hi)
#define SEAM(k) do { if (IN(k) && IN((k) + 1)) xcd_barrier(bar); } while (0)
    if (IN(0)) { ph_prologue(p, lds); ph_xnorm(p); }
    SEAM(0);
    if (IN(1)) { EpiProjM e{(bf16*)(ws + WS_PR), (bf16*)(ws + WS_U), (bf16*)(ws + WS_GATES), p.out};
        ph_mfma_gemm(lds, (const bf16*)(ws + WS_XN), (const bf16*)(ws + WS_WT_IN), 4352, 1024, e); }
    SEAM(1);
    if (IN(2)) {
        for (int item = blockIdx.x; item < ((NB + NS) / NWAVES) * NH; item += gridDim.x) ph_rwkv_item(p, lds, item);
        const int gw = blockIdx.x * NWAVES + (threadIdx.x >> 6), NGW = gridDim.x * NWAVES;
        for (int it = (gw + NGW / 2) % NGW; it < (NB + NS) * SG; it += NGW) ph_s5_item(p, it);
    }
    SEAM(2);
    if (IN(3)) { EpiA1M e{(const bf16*)(ws + WS_GATES), (bf16*)(ws + WS_MERGED)};
        ph_mfma_gemm(lds, (const bf16*)(ws + WS_OA), (const bf16*)(ws + WS_WT_RO), 1024, 512, e); }
    SEAM(3);
    if (IN(4)) { EpiGluM e{(const bf16*)(ws + WS_GATES), p.in[32], p.in[34], (bf16*)(ws + WS_MERGED)};
        ph_mfma_gemm(lds, (const bf16*)(ws + WS_HGL), (const bf16*)(ws + WS_WT_GLU), 2048, 512, e); }
    SEAM(4);
    if (IN(5)) { EpiF32M e{(float*)(ws + WS_MIX), D};
        ph_mfma_gemm(lds, (const bf16*)(ws + WS_MERGED), (const bf16*)(ws + WS_WT_MO), 1024, 1024, e); }
    SEAM(5);
    if (IN(6)) ph_row1(p);
    SEAM(6);
    if (IN(7)) { EpiSwigluM e{(bf16*)(ws + WS_HFF)};
        ph_mfma_gemm(lds, (const bf16*)(ws + WS_H2), (const bf16*)(ws + WS_WT_GU), 5632, 1024, e); }
    SEAM(7);
    if (IN(8)) { EpiF32M e{(float*)(ws + WS_F), D};
        ph_mfma_gemm(lds, (const bf16*)(ws + WS_HFF), (const bf16*)(ws + WS_WT_DN), 1024, FF, e); }
    SEAM(8);
    if (IN(9)) ph_row2(p);
#undef IN
#undef SEAM
}

#ifndef MK_N_LAUNCHES
#define MK_N_LAUNCHES 1
#endif
extern "C" void kernel_launch(void* const* d_in, const int* in_sizes, int n_in, void* d_out, int out_size, void* d_ws, size_t ws_size, hipStream_t stream) {
    static int grid = 0;
    if (grid == 0) {
        if (n_in != 39 || out_size != (int)O_END || ws_size < 256 * MiB) { fprintf(stderr, "kernel_launch: unexpected sizes n_in %d out %d ws %zu\n", n_in, out_size, ws_size); grid = -1; return; }
        int dev = 0, cus = 0;
        if (hipGetDevice(&dev) != hipSuccess || hipDeviceGetAttribute(&cus, hipDeviceAttributeMultiprocessorCount, dev) != hipSuccess) { grid = -1; return; }
        if (hipFuncSetAttribute((const void*)mk_fwd, hipFuncAttributeMaxDynamicSharedMemorySize, LDS_BYTES) != hipSuccess) { fprintf(stderr, "kernel_launch: hipFuncSetAttribute failed\n"); grid = -1; return; }
        grid = cus;
    }
    if (grid < 0) return;
    if (hipMemsetAsync((char*)d_ws + WS_CTL, 0, CTL_ZERO_BYTES, stream) != hipSuccess) return;
    P p{};
    for (int i = 0; i < 39; ++i) p.in[i] = (const float*)d_in[i];
    p.out = (float*)d_out; p.ws = (unsigned char*)d_ws;
    if (MK_N_LAUNCHES == 1) { p.ph_lo = 0; p.ph_hi = N_PHASES; hipLaunchKernelGGL(mk_fwd, dim3(grid), dim3(NTHR), LDS_BYTES, stream, p); }
    else for (int k = 0; k < N_PHASES; ++k) { p.ph_lo = k; p.ph_hi = k + 1; hipLaunchKernelGGL(mk_fwd, dim3(grid), dim3(NTHR), LDS_BYTES, stream, p); }
}
```

```cpp
#include <hip/hip_runtime.h>
#include <cstdint>
#include <cstdio>

constexpr int D = 1024, NB = 8, T = 2048, NS = 128;
constexpr int MP = NB * T;
constexpr int M = MP + NS;
constexpr int RW = 512, HN = 64, NH = 8;
constexpr int SHIFT = 1664, PROJ = 4224;
constexpr int SG = 32, SP = 64, SC = 16;
constexpr int FF = 2816;
constexpr float NORM_EPS = 1e-6f, LNX_EPS = 64e-5f;

typedef unsigned short bf16;
__device__ __forceinline__ float bf2f(bf16 v) { return __uint_as_float((unsigned)v << 16); }
__device__ __forceinline__ bf16 f2bf(float f) { unsigned u = __float_as_uint(f); return (bf16)((u + 0x7fffu + ((u >> 16) & 1u)) >> 16); }
__device__ __forceinline__ float wave_sum(float v) {
#pragma unroll
    for (int o = 1; o < 64; o <<= 1) v += __shfl_xor(v, o);
    return v;
}
__device__ __forceinline__ float sigmoidf_(float x) { return 1.f / (1.f + __expf(-x)); }

constexpr size_t O_Y = 0;
constexpr size_t O_SHIFT_P = (size_t)M * D;
constexpr size_t O_WKV_P = O_SHIFT_P + (size_t)NB * SHIFT;
constexpr size_t O_S5RE_P = O_WKV_P + (size_t)NB * NH * HN * HN;
constexpr size_t O_S5IM_P = O_S5RE_P + (size_t)NB * SG * SP;
constexpr size_t O_SHIFT_S = O_S5IM_P + (size_t)NB * SG * SP;
constexpr size_t O_WKV_S = O_SHIFT_S + (size_t)NS * SHIFT;
constexpr size_t O_S5RE_S = O_WKV_S + (size_t)NS * NH * HN * HN;
constexpr size_t O_S5IM_S = O_S5RE_S + (size_t)NS * SG * SP;
constexpr size_t O_END = O_S5IM_S + (size_t)NS * SG * SP;
static_assert(O_END == 22148096, "d_out size");

constexpr size_t MiB = 1u << 20;
constexpr int MPAD = 16640;
constexpr size_t WS_WT_IN = 1 * MiB;
constexpr size_t WS_WT_RO = WS_WT_IN + 4352 * 1024 * 2;
constexpr size_t WS_WT_GLU = WS_WT_RO + 1024 * 512 * 2;
constexpr size_t WS_WT_MO = WS_WT_GLU + 2048 * 512 * 2;
constexpr size_t WS_WT_GU = WS_WT_MO + 1024 * 1024 * 2;
constexpr size_t WS_WT_DN = WS_WT_GU + 5632 * 1024 * 2;
static_assert(WS_WT_DN + 1024 * 2816 * 2 <= 33 * MiB, "weights region");
constexpr size_t WS_XN = 33 * MiB;
constexpr size_t WS_PR = 66 * MiB;
constexpr size_t WS_U = 119 * MiB;
constexpr size_t WS_GATES = 136 * MiB;
constexpr size_t WS_OA = 217 * MiB;
constexpr size_t WS_HGL = 234 * MiB;
constexpr size_t WS_MERGED = WS_XN;
constexpr size_t WS_MIX = WS_PR;
constexpr size_t WS_H2 = WS_XN;
constexpr size_t WS_HFF = WS_PR;
constexpr size_t WS_F = 156 * MiB;

struct P {
    const float* in[39];
    float* out;
    unsigned char* ws;
    int ph_lo, ph_hi;
};
constexpr int NWAVES = 8, NTHR = NWAVES * 64;
constexpr int LDS_BYTES = 147456, MISC_OFF = 131072 + 320;
#define LAS __attribute__((address_space(3)))
constexpr size_t WS_CTL = 0, CTL_ZERO_BYTES = 1 * MiB;
constexpr int CW_BAR = 4096;

__device__ __forceinline__ const float* xrow(const P& p, int r) { return r < MP ? p.in[0] + (size_t)r * D : p.in[1] + (size_t)(r - MP) * D; }


#define XB_TMO      128
#define XB_XCNT(j)  (256  + 64 * (j))
#define XB_XSUB(j)  (1280 + 64 * (j))
#define XB_XGEN(j)  (2304 + 64 * (j))
#define XB_TOP      3328
#define XB_TOPGEN   3392
#define XCD_BAR_WORDS 3456
#define XB_SPIN_CAP (1u << 18)
__device__ __forceinline__ unsigned xb_ld(unsigned* p)              { return __hip_atomic_load(p, __ATOMIC_RELAXED, __HIP_MEMORY_SCOPE_AGENT); }
__device__ __forceinline__ unsigned xb_add(unsigned* p, unsigned v) { return __hip_atomic_fetch_add(p, v, __ATOMIC_RELAXED, __HIP_MEMORY_SCOPE_AGENT); }
__device__ __forceinline__ unsigned xb_xcc_id() { return (unsigned)__builtin_amdgcn_s_getreg((3 << 11) | 20) & 0xFu; }
#define XB_SPIN(cond, bar) do { unsigned _sp = 0; while (cond) { __builtin_amdgcn_s_sleep(1); \
    if ((++_sp & 255u) == 0u) { if (xb_ld(&(bar)[XB_TMO])) break; if (_sp > XB_SPIN_CAP) { atomicAdd(&(bar)[XB_TMO], 1u); break; } } } } while (0)
struct XcdBarrier { unsigned* bar; unsigned x; volatile LAS unsigned* st; };
__device__ __forceinline__ XcdBarrier xcd_barrier_post(unsigned* bar, volatile LAS unsigned* st) {
    XcdBarrier b; b.bar = bar; b.x = xb_xcc_id(); b.st = st;
    if (threadIdx.x == 0) (void)xb_add(&bar[XB_XCNT(b.x)], 1u);
    return b;
}
__device__ __forceinline__ void xcd_barrier_complete(unsigned* bar, unsigned x, unsigned& nloc, unsigned& nx) {
    const unsigned G = gridDim.x * gridDim.y * gridDim.z;
    unsigned sum, cnt, mine, sp = 0u;
    for (;;) {
        sum = 0u; cnt = 0u; mine = 0u;
#pragma unroll
        for (unsigned j = 0; j < 16; ++j) { const unsigned c = xb_ld(&bar[XB_XCNT(j)]); sum += c; cnt += (c > 0u) ? 1u : 0u; mine = (j == x) ? c : mine; }
        if (sum == G) break;
        __builtin_amdgcn_s_sleep(1);
        if ((++sp & 255u) == 0u) { if (xb_ld(&bar[XB_TMO])) break; if (sp > XB_SPIN_CAP) { atomicAdd(&bar[XB_TMO], 1u); break; } }
    }
    nloc = mine > 0u ? mine : 1u; nx = cnt > 0u ? cnt : 1u;
}
__device__ __forceinline__ void xcd_barrier(const XcdBarrier& b) {
    asm volatile("s_waitcnt vmcnt(0)" ::: "memory");
    __syncthreads();
    if (threadIdx.x == 0) {
        unsigned* bar = b.bar;
        __builtin_amdgcn_s_waitcnt(0);
        unsigned nloc = b.st[0], nx = b.st[1];
        if (nloc == 0u) { xcd_barrier_complete(bar, b.x, nloc, nx); b.st[0] = nloc; b.st[1] = nx; }
        const unsigned old = xb_add(&bar[XB_XSUB(b.x)], 1u);
        const unsigned gen = old / nloc;
        if (old + 1u == (gen + 1u) * nloc) {
            __builtin_amdgcn_fence(__ATOMIC_RELEASE, "agent");
            asm volatile("s_waitcnt vmcnt(0)" ::: "memory");
            const unsigned og = xb_add(&bar[XB_TOP], 1u);
            const unsigned tg = og / nx;
            if (og + 1u == (tg + 1u) * nx) xb_add(&bar[XB_TOPGEN], 1u);
            else XB_SPIN(xb_ld(&bar[XB_TOPGEN]) == tg, bar);
            __builtin_amdgcn_fence(__ATOMIC_ACQUIRE, "agent");
            xb_add(&bar[XB_XGEN(b.x)], 1u);
            asm volatile("s_waitcnt vmcnt(0)" ::: "memory");
        } else {
            XB_SPIN(xb_ld(&bar[XB_XGEN(b.x)]) == gen, bar);
            __builtin_amdgcn_fence(__ATOMIC_ACQUIRE, "agent");
            asm volatile("s_waitcnt vmcnt(0)" ::: "memory");
        }
    }
    __syncthreads();
}

namespace pg8 {
#define PG8_LAS __attribute__((address_space(3)))
typedef unsigned short bf16_t;
typedef short bf16x8 __attribute__((ext_vector_type(8)));
typedef float f32x4 __attribute__((ext_vector_type(4)));
typedef unsigned u32x4 __attribute__((ext_vector_type(4)));
constexpr int BM = 256, BK = 64, HALF = 128, HTB = HALF * BK * 2  , STAGE_BYTES = 8 * HTB, NXCD = 8, WGM = 8;

__host__ __device__ __forceinline__ int lds_byte(int r, int c) { const int st = (r >> 4) * 2 + (c >> 5), rr = r & 15, cc = c & 31, ob = rr * 64 + cc * 2; return st * 1024 + (ob ^ (((ob >> 9) & 1) << 5)); }
__host__ __device__ __forceinline__ void stage_rc(int b, int& R, int& C) { const int st = b / 1024, sb = b % 1024, swz = sb ^ (((sb >> 9) & 1) << 5); R = (st >> 1) * 16 + swz / 64; C = (st & 1) * 32 + (swz % 64) / 2; }
__host__ __device__ __forceinline__ int perm32(int rho) { const int n = rho >> 4, i = rho & 15; return 8 * (i >> 2) + 4 * n + (i & 3); }

struct Unit { int pm, pn; };
struct Gemm { const bf16_t* A; const bf16_t* Bt; int M, N, K; };

struct StaticOrder {
    int nM, nN, nwg, G, c;
    __host__ __device__ void init(int M, int N, int G_, int c_) { nM = M / BM; nN = N / BM; nwg = nM * nN; G = G_; c = c_; }
    __host__ __device__ bool next(int i, Unit& u) const {
        const long L = (long)i * G + c; if (L >= nwg) return false;
        int wgid = (int)L; { const int q = nwg / NXCD, r = nwg % NXCD, xcd = wgid % NXCD, off = wgid / NXCD; wgid = (xcd < r ? xcd * (q + 1) : r * (q + 1) + (xcd - r) * q) + off; }
        const int nig = WGM * nN, gid = wgid / nig, fm = gid * WGM, gsz = (nM - fm) < WGM ? (nM - fm) : WGM;
        u.pm = fm + ((wgid % nig) % gsz); u.pn = (wgid % nig) / gsz; return true;
    }
    __device__ __forceinline__ void a_ready(const Unit&) const {}
    __device__ __forceinline__ void done(const Unit&) const {}
};

typedef __bf16 bf16x2_t __attribute__((ext_vector_type(2)));
typedef float f32x2_t __attribute__((ext_vector_type(2)));
__device__ __forceinline__ unsigned cvt_pk_bf16(float lo, float hi) { f32x2_t v = {lo, hi}; bf16x2_t b = __builtin_convertvector(v, bf16x2_t); return __builtin_bit_cast(unsigned, b); }
template <class Epi, class Sched, bool ALIGN_EPI = false, bool SP2 = false>
__device__ __forceinline__ void gemm_phase(PG8_LAS unsigned char* lds, const Gemm g, const Sched& S, const Epi& E) {
    const int tid = threadIdx.x, wid = __builtin_amdgcn_readfirstlane(tid >> 6), lane = tid & 63, wr = wid >> 2, wc = wid & 3, fr = lane & 15, fq = lane >> 4;
    const int K = g.K, nt = K / BK;
    unsigned voffA[2], voffB[2];
#pragma unroll
    for (int i = 0; i < 2; ++i) { int R, C; stage_rc(tid * 16 + i * 8192, R, C); const int Rb = Epi::PERM ? ((R & ~31) + perm32(R & 31)) : R;
        voffA[i] = (unsigned)(R * K + C) * 2u; voffB[i] = (unsigned)(Rb * K + C) * 2u; }
    const size_t kstep = (size_t)(BK * 2);
    const size_t hstep = (size_t)HALF * K * 2;
    const size_t tstep = 2 * hstep;
    const unsigned ldsw = (unsigned)wid * 1024u;
    const int aoff = lds_byte(wr * 64 + fr, fq * 8), boff = lds_byte(wc * 32 + fr, fq * 8);
#define PG8_SA(b, h) (((b) * 2 + (h)) * HTB)
#define PG8_SB(b, h) ((4 + (b) * 2 + (h)) * HTB)
#define PG8_STAGE(bufoff, gbase, voff) do { _Pragma("unroll") for (int _i = 0; _i < 2; ++_i) \
        __builtin_amdgcn_global_load_lds((const unsigned*)((const char*)(gbase) + (voff)[_i]), (PG8_LAS unsigned*)(lds + (bufoff) + ldsw + _i * 8192), 16, 0, 0); } while (0)
#define PG8_LDA(dst, b, h) do { _Pragma("unroll") for (int m = 0; m < 4; ++m) _Pragma("unroll") for (int k = 0; k < 2; ++k) dst[m][k] = *(const PG8_LAS bf16x8*)(lds + PG8_SA(b, h) + aoff + m * 2048 + k * 1024); } while (0)
#define PG8_LDB(dst, b, h) do { _Pragma("unroll") for (int n = 0; n < 2; ++n) _Pragma("unroll") for (int k = 0; k < 2; ++k) dst[n][k] = *(const PG8_LAS bf16x8*)(lds + PG8_SB(b, h) + boff + n * 2048 + k * 1024); } while (0)
#define PG8_MMA(ai, bj, At, Bt) do { __builtin_amdgcn_s_setprio(1); _Pragma("unroll") for (int m = 0; m < 4; ++m) _Pragma("unroll") for (int n = 0; n < 2; ++n) _Pragma("unroll") for (int k = 0; k < 2; ++k) \
        acc[ai][bj][m][n] = __builtin_amdgcn_mfma_f32_16x16x32_bf16(Bt[n][k], At[m][k], acc[ai][bj][m][n], 0, 0, 0); __builtin_amdgcn_s_setprio(0); } while (0)
#define PG8_WAIT_V(n) asm volatile("s_waitcnt vmcnt(" #n ")" ::: "memory")
#define PG8_WAIT_L(n) asm volatile("s_waitcnt lgkmcnt(" #n ")" ::: "memory")
#define PG8_BAR __builtin_amdgcn_s_barrier()
#define PG8_SCHED __builtin_amdgcn_sched_barrier(0)
    Unit cur, nxt; int ui = 0;
    if (!S.next(0, cur)) return;
    f32x4 acc[2][2][4][2];
#pragma unroll
    for (int a = 0; a < 2; ++a)
#pragma unroll
        for (int b = 0; b < 2; ++b)
#pragma unroll
            for (int m = 0; m < 4; ++m)
#pragma unroll
                for (int n = 0; n < 2; ++n) acc[a][b][m][n] = (f32x4){0.f, 0.f, 0.f, 0.f};
    bf16x8 At[4][2], B0[2][2], B1[2][2];
    const char* cA = (const char*)g.A + (size_t)cur.pm * tstep; const char* cB = (const char*)g.Bt + (size_t)cur.pn * tstep;
    S.a_ready(cur);
    if constexpr (SP2) {
        PG8_STAGE(PG8_SB(0, 0), cB, voffB); PG8_STAGE(PG8_SB(0, 1), cB + hstep, voffB); PG8_STAGE(PG8_SA(0, 0), cA, voffA); PG8_STAGE(PG8_SA(0, 1), cA + hstep, voffA);
        if (wr == 1) PG8_BAR;
        PG8_WAIT_V(2); PG8_BAR;
        PG8_STAGE(PG8_SB(1, 0), cB + kstep, voffB); PG8_STAGE(PG8_SA(1, 0), cA + kstep, voffA); PG8_STAGE(PG8_SB(1, 1), cB + hstep + kstep, voffB);
        PG8_WAIT_V(6); PG8_BAR;
    } else {
        PG8_STAGE(PG8_SB(0, 0), cB, voffB); PG8_STAGE(PG8_SA(0, 0), cA, voffA); PG8_STAGE(PG8_SB(0, 1), cB + hstep, voffB); PG8_STAGE(PG8_SA(0, 1), cA + hstep, voffA);
        if (wr == 1) PG8_BAR;
        PG8_WAIT_V(4); PG8_BAR;
        PG8_STAGE(PG8_SB(1, 0), cB + kstep, voffB); PG8_STAGE(PG8_SA(1, 0), cA + kstep, voffA); PG8_STAGE(PG8_SB(1, 1), cB + hstep + kstep, voffB);
        PG8_WAIT_V(6); PG8_BAR;
    }
    for (;;) {
        const bool has_next = S.next(ui + 1, nxt);
        const char* nA = has_next ? (const char*)g.A + (size_t)nxt.pm * tstep : cA; const char* nB = has_next ? (const char*)g.Bt + (size_t)nxt.pn * tstep : cB;
        for (int t = 0; t < nt; t += 2) {
            const bool last = (t == nt - 2);
            const char* a1 = cA + (size_t)(t + 1) * kstep;
            const char* a2 = last ? nA : cA + (size_t)(t + 2) * kstep; const char* b2 = last ? nB : cB + (size_t)(t + 2) * kstep;
            const char* a3 = a2 + kstep; const char* b3 = b2 + kstep;
            if (last && has_next) S.a_ready(nxt);
            if constexpr (SP2) {
            PG8_LDB(B0, 0, 0); PG8_LDB(B1, 0, 1); PG8_SCHED; PG8_LDA(At, 0, 0); PG8_STAGE(PG8_SA(1, 1), a1 + hstep, voffA);
            PG8_WAIT_V(8); PG8_WAIT_L(0); PG8_BAR; PG8_MMA(0, 0, At, B0); PG8_MMA(0, 1, At, B1); PG8_BAR; PG8_SCHED;
            PG8_LDA(At, 0, 1); PG8_STAGE(PG8_SB(0, 0), b2, voffB); PG8_STAGE(PG8_SB(0, 1), b2 + hstep, voffB); PG8_STAGE(PG8_SA(0, 0), a2, voffA);
            PG8_WAIT_V(8); PG8_WAIT_L(0); PG8_BAR; PG8_MMA(1, 0, At, B0); PG8_MMA(1, 1, At, B1); PG8_BAR; PG8_SCHED;
            PG8_LDB(B0, 1, 0); PG8_LDB(B1, 1, 1); PG8_SCHED; PG8_LDA(At, 1, 0); PG8_STAGE(PG8_SA(0, 1), a2 + hstep, voffA);
            PG8_WAIT_V(8); PG8_WAIT_L(0); PG8_BAR; PG8_MMA(0, 0, At, B0); PG8_MMA(0, 1, At, B1); PG8_BAR; PG8_SCHED;
            PG8_LDA(At, 1, 1); PG8_STAGE(PG8_SB(1, 0), b3, voffB); PG8_STAGE(PG8_SB(1, 1), b3 + hstep, voffB); PG8_STAGE(PG8_SA(1, 0), a3, voffA);
            PG8_WAIT_V(8); PG8_WAIT_L(0); PG8_BAR; PG8_MMA(1, 0, At, B0); PG8_MMA(1, 1, At, B1); PG8_BAR; PG8_SCHED;
            } else {
            PG8_LDB(B0, 0, 0); PG8_SCHED; PG8_LDA(At, 0, 0); PG8_STAGE(PG8_SA(1, 1), a1 + hstep, voffA);
            PG8_WAIT_L(8); PG8_BAR; PG8_WAIT_L(0); PG8_MMA(0, 0, At, B0); PG8_BAR; PG8_SCHED;
            PG8_LDB(B1, 0, 1); PG8_STAGE(PG8_SB(0, 0), b2, voffB);
            PG8_BAR; PG8_WAIT_L(0); PG8_MMA(0, 1, At, B1); PG8_BAR;
            PG8_LDA(At, 0, 1); PG8_STAGE(PG8_SA(0, 0), a2, voffA);
            PG8_BAR; PG8_WAIT_L(0); PG8_MMA(1, 0, At, B0); PG8_BAR; PG8_SCHED;
            PG8_STAGE(PG8_SB(0, 1), b2 + hstep, voffB);
            PG8_WAIT_V(6); PG8_BAR; PG8_MMA(1, 1, At, B1); PG8_BAR;
            PG8_LDB(B0, 1, 0); PG8_SCHED; PG8_LDA(At, 1, 0); PG8_STAGE(PG8_SA(0, 1), a2 + hstep, voffA);
            PG8_WAIT_L(8); PG8_BAR; PG8_WAIT_L(0); PG8_MMA(0, 0, At, B0); PG8_BAR; PG8_SCHED;
            PG8_LDB(B1, 1, 1); PG8_STAGE(PG8_SB(1, 0), b3, voffB);
            PG8_BAR; PG8_WAIT_L(0); PG8_MMA(0, 1, At, B1); PG8_BAR;
            PG8_LDA(At, 1, 1); PG8_STAGE(PG8_SA(1, 0), a3, voffA);
            PG8_BAR; PG8_WAIT_L(0); PG8_MMA(1, 0, At, B0); PG8_BAR; PG8_SCHED;
            PG8_STAGE(PG8_SB(1, 1), b3 + hstep, voffB);
            PG8_WAIT_V(6); PG8_BAR; PG8_MMA(1, 1, At, B1); PG8_BAR;
            }
        }
        if constexpr (ALIGN_EPI) { if (wr == 0) PG8_BAR; }
        if constexpr (!Epi::AFTER_DRAIN) { E(acc, cur, wr, wc, fr, fq); S.done(cur); }
        if (!has_next) break;
#pragma unroll
        for (int a = 0; a < 2; ++a)
#pragma unroll
            for (int b = 0; b < 2; ++b)
#pragma unroll
                for (int m = 0; m < 4; ++m)
#pragma unroll
                    for (int n = 0; n < 2; ++n) acc[a][b][m][n] = (f32x4){0.f, 0.f, 0.f, 0.f};
        cur = nxt; cA = nA; cB = nB; ++ui;
        if constexpr (ALIGN_EPI) { if (wr == 1) PG8_BAR; }
    }
    PG8_WAIT_V(0);
    if constexpr (!ALIGN_EPI) { if (wr == 0) PG8_BAR; }
    PG8_BAR;
    if constexpr (Epi::AFTER_DRAIN) { E.fused(acc, cur, wr, wc, fr, fq, lds, wid, lane); S.done(cur); }
#undef PG8_SA
#undef PG8_SB
#undef PG8_STAGE
#undef PG8_LDA
#undef PG8_LDB
#undef PG8_MMA
#undef PG8_WAIT_V
#undef PG8_WAIT_L
#undef PG8_BAR
#undef PG8_SCHED
}
}

typedef pg8::f32x4 f32x4;
typedef pg8::u32x4 u32x4;
__device__ __forceinline__ u32x4 pack8(const f32x4& a, const f32x4& b) { u32x4 w; w.x = pg8::cvt_pk_bf16(a[0], a[1]); w.y = pg8::cvt_pk_bf16(a[2], a[3]); w.z = pg8::cvt_pk_bf16(b[0], b[1]); w.w = pg8::cvt_pk_bf16(b[2], b[3]); return w; }
__device__ __forceinline__ void unpack8(const u32x4& w, f32x4& a, f32x4& b) {
    a[0] = __uint_as_float(w.x << 16); a[1] = __uint_as_float(w.x & 0xffff0000u); a[2] = __uint_as_float(w.y << 16); a[3] = __uint_as_float(w.y & 0xffff0000u);
    b[0] = __uint_as_float(w.z << 16); b[1] = __uint_as_float(w.z & 0xffff0000u); b[2] = __uint_as_float(w.w << 16); b[3] = __uint_as_float(w.w & 0xffff0000u); }
__device__ __forceinline__ f32x4 sig4(const f32x4& v) { f32x4 r; r[0] = sigmoidf_(v[0]); r[1] = sigmoidf_(v[1]); r[2] = sigmoidf_(v[2]); r[3] = sigmoidf_(v[3]); return r; }

struct EpiProjM {
    static constexpr bool PERM = true, AFTER_DRAIN = false;
    bf16 *pr, *u, *gates; float* out;
    __device__ __forceinline__ void operator()(const f32x4 (&acc)[2][2][4][2], const pg8::Unit& un, int wr, int wc, int fr, int fq) const {
#pragma unroll
        for (int bj = 0; bj < 2; ++bj) {
            const int col = un.pn * 256 + bj * 128 + wc * 32 + 8 * fq;
            if (col >= PROJ) continue;
#pragma unroll
            for (int ai = 0; ai < 2; ++ai)
#pragma unroll
                for (int m = 0; m < 4; ++m) {
                    const int row = un.pm * 256 + ai * 128 + wr * 64 + m * 16 + fr;
                    const f32x4 v0 = acc[ai][bj][m][0], v1 = acc[ai][bj][m][1];
                    if (col < SHIFT) {
                        *(u32x4*)(pr + (size_t)row * SHIFT + col) = pack8(v0, v1);
                        float* o = nullptr;
                        if (row < MP) { if ((row & (T - 1)) == T - 1) o = out + O_SHIFT_P + (size_t)(row / T) * SHIFT + col; }
                        else if (row < M) o = out + O_SHIFT_S + (size_t)(row - MP) * SHIFT + col;
                        if (o) { *(f32x4*)o = v0; *(f32x4*)(o + 4) = v1; }
                    } else if (col < SHIFT + 512) *(u32x4*)(u + (size_t)row * 512 + (col - SHIFT)) = pack8(v0, v1);
                    else *(u32x4*)(gates + (size_t)row * 2048 + (col - SHIFT - 512)) = pack8(sig4(v0), sig4(v1));
                }
        }
    }
};
struct EpiA1M {
    static constexpr bool PERM = true, AFTER_DRAIN = false;
    const bf16* gates; bf16* merged;
    __device__ __forceinline__ void operator()(const f32x4 (&acc)[2][2][4][2], const pg8::Unit& un, int wr, int wc, int fr, int fq) const {
#pragma unroll
        for (int ai = 0; ai < 2; ++ai)
#pragma unroll
            for (int m = 0; m < 4; ++m) {
                const int row = un.pm * 256 + ai * 128 + wr * 64 + m * 16 + fr;
#pragma unroll
                for (int bj = 0; bj < 2; ++bj) {
                    const int col = un.pn * 256 + bj * 128 + wc * 32 + 8 * fq;
                    f32x4 g0, g1; unpack8(*(const u32x4*)(gates + (size_t)row * 2048 + col), g0, g1);
                    *(u32x4*)(merged + (size_t)row * D + col) = pack8(acc[ai][bj][m][0] * g0, acc[ai][bj][m][1] * g1);
                }
            }
    }
};
struct EpiGluM {
    static constexpr bool PERM = true, AFTER_DRAIN = false;
    const bf16* gates; const float *b1, *b2; bf16* merged;
    __device__ __forceinline__ void operator()(const f32x4 (&acc)[2][2][4][2], const pg8::Unit& un, int wr, int wc, int fr, int fq) const {
        const int col = un.pn * 128 + wc * 32 + 8 * fq;
        const f32x4 b1a = *(const f32x4*)(b1 + col), b1b = *(const f32x4*)(b1 + col + 4), b2a = *(const f32x4*)(b2 + col), b2b = *(const f32x4*)(b2 + col + 4);
#pragma unroll
        for (int ai = 0; ai < 2; ++ai)
#pragma unroll
            for (int m = 0; m < 4; ++m) {
                const int row = un.pm * 256 + ai * 128 + wr * 64 + m * 16 + fr;
                f32x4 g0, g1, t0, t1; unpack8(*(const u32x4*)(gates + (size_t)row * 2048 + 1024 + col), g0, g1); unpack8(*(const u32x4*)(merged + (size_t)row * D + col), t0, t1);
                const f32x4 o0 = t0 + g0 * ((acc[ai][0][m][0] + b1a) * sig4(acc[ai][1][m][0] + b2a));
                const f32x4 o1 = t1 + g1 * ((acc[ai][0][m][1] + b1b) * sig4(acc[ai][1][m][1] + b2b));
                *(u32x4*)(merged + (size_t)row * D + col) = pack8(o0, o1);
            }
    }
};
struct EpiF32M {
    static constexpr bool PERM = false, AFTER_DRAIN = false;
    float* o; int ld;
    __device__ __forceinline__ void operator()(const f32x4 (&acc)[2][2][4][2], const pg8::Unit& un, int wr, int wc, int fr, int fq) const {
#pragma unroll
        for (int ai = 0; ai < 2; ++ai)
#pragma unroll
            for (int m = 0; m < 4; ++m) {
                const int row = un.pm * 256 + ai * 128 + wr * 64 + m * 16 + fr;
#pragma unroll
                for (int bj = 0; bj < 2; ++bj)
#pragma unroll
                    for (int n = 0; n < 2; ++n) *(f32x4*)(o + (size_t)row * ld + un.pn * 256 + bj * 128 + wc * 32 + 16 * n + 4 * fq) = acc[ai][bj][m][n];
            }
    }
};
struct EpiSwigluM {
    static constexpr bool PERM = true, AFTER_DRAIN = false;
    bf16* o;
    __device__ __forceinline__ void operator()(const f32x4 (&acc)[2][2][4][2], const pg8::Unit& un, int wr, int wc, int fr, int fq) const {
        const int col = un.pn * 128 + wc * 32 + 8 * fq;
#pragma unroll
        for (int ai = 0; ai < 2; ++ai)
#pragma unroll
            for (int m = 0; m < 4; ++m) {
                const int row = un.pm * 256 + ai * 128 + wr * 64 + m * 16 + fr;
                const f32x4 g0 = acc[ai][0][m][0], g1 = acc[ai][0][m][1];
                *(u32x4*)(o + (size_t)row * FF + col) = pack8(g0 * sig4(g0) * acc[ai][1][m][0], g1 * sig4(g1) * acc[ai][1][m][1]);
            }
    }
};

__device__ __forceinline__ void tr_item(const float* W, int K, int N, bf16* WT, int k0, int n0, int drow0, LAS float* scr, int lane) {
#pragma unroll 8
    for (int i = 0; i < 32; ++i) { const int kk = 2 * i + (lane >> 5); scr[kk * 33 + (lane & 31)] = W[(size_t)(k0 + kk) * N + n0 + (lane & 31)]; }
    asm volatile("s_waitcnt lgkmcnt(0)" ::: "memory");
    const int c = lane & 7;
#pragma unroll
    for (int j = 0; j < 4; ++j) { const int n = (lane >> 3) + 8 * j; const LAS float* s = scr + (8 * c) * 33 + n;
        u32x4 o; o.x = pg8::cvt_pk_bf16(s[0 * 33], s[1 * 33]); o.y = pg8::cvt_pk_bf16(s[2 * 33], s[3 * 33]); o.z = pg8::cvt_pk_bf16(s[4 * 33], s[5 * 33]); o.w = pg8::cvt_pk_bf16(s[6 * 33], s[7 * 33]);
        *(u32x4*)(WT + (size_t)(drow0 + n) * K + k0 + 8 * c) = o; }
    asm volatile("s_waitcnt lgkmcnt(0)" ::: "memory");
}
__device__ __forceinline__ bool tr_seg(int& r, const float* W, int K, int N, bf16* WT, int mode, LAS float* scr, int lane) {
    const int nblk = N / 32, items = (K / 64) * nblk;
    if (r >= items) { r -= items; return false; }
    const int kb = r / nblk, nb = r % nblk, n0 = 32 * nb;
    const int drow0 = mode == 0 ? n0 : 256 * (n0 / 128) + 128 * (mode - 1) + (n0 % 128);
    tr_item(W, K, N, WT, 64 * kb, n0, drow0, scr, lane);
    return true;
}
__device__ __forceinline__ void ph_prologue(const P& p, LAS unsigned char* lds) {
    const int lane = threadIdx.x & 63, wv = threadIdx.x >> 6, gw = blockIdx.x * NWAVES + wv, NGW = gridDim.x * NWAVES;
    LAS float* scr = (LAS float*)(lds + wv * 16384);
    unsigned char* ws = p.ws;
    constexpr int NITEMS = 16 * 132 + 8 * 32 * 3 + 16 * 32 + 16 * 88 * 2 + 44 * 32;
    for (int it = gw; it < NITEMS; it += NGW) {
        int r = it;
        if (tr_seg(r, p.in[10], 1024, PROJ, (bf16*)(ws + WS_WT_IN), 0, scr, lane)) continue;
        if (tr_seg(r, p.in[22], 512, 1024, (bf16*)(ws + WS_WT_RO), 0, scr, lane)) continue;
        if (tr_seg(r, p.in[31], 512, 1024, (bf16*)(ws + WS_WT_GLU), 1, scr, lane)) continue;
        if (tr_seg(r, p.in[33], 512, 1024, (bf16*)(ws + WS_WT_GLU), 2, scr, lane)) continue;
        if (tr_seg(r, p.in[35], 1024, 1024, (bf16*)(ws + WS_WT_MO), 0, scr, lane)) continue;
        if (tr_seg(r, p.in[36], 1024, FF, (bf16*)(ws + WS_WT_GU), 1, scr, lane)) continue;
        if (tr_seg(r, p.in[37], 1024, FF, (bf16*)(ws + WS_WT_GU), 2, scr, lane)) continue;
        tr_seg(r, p.in[38], FF, 1024, (bf16*)(ws + WS_WT_DN), 0, scr, lane);
    }
}
template <class Epi>
__device__ __forceinline__ void ph_mfma_gemm(LAS unsigned char* lds, const bf16* A, const bf16* Bt, int N, int K, const Epi& e) {
    pg8::Gemm g{A, Bt, MPAD, N, K}; pg8::StaticOrder S; S.init(MPAD, N, (int)gridDim.x, (int)blockIdx.x);
    pg8::gemm_phase<Epi, pg8::StaticOrder, true, true>(lds, g, S, e);
}

__device__ __forceinline__ void ph_xnorm(const P& p) {
    const int lane = threadIdx.x & 63, gw = blockIdx.x * NWAVES + (threadIdx.x >> 6), NGW = gridDim.x * NWAVES;
    const float* g = p.in[6];
    bf16* xn = (bf16*)(p.ws + WS_XN);
    for (int r = gw; r < M; r += NGW) {
        const float* x = xrow(p, r);
        float v[16]; float s = 0.f;
#pragma unroll
        for (int j = 0; j < 16; ++j) { v[j] = x[lane + 64 * j]; s += v[j] * v[j]; }
        s = wave_sum(s);
        const float rs = rsqrtf(s * (1.f / D) + NORM_EPS);
#pragma unroll
        for (int j = 0; j < 16; ++j) xn[(size_t)r * D + lane + 64 * j] = f2bf(v[j] * rs * g[lane + 64 * j]);
    }
}

template <int NW> struct GemmArgs { const bf16* A[NW]; const float* W[NW]; int lda[NW]; int K[NW]; int Mrows, N; };
template <int NW, class Epi>
__device__ __forceinline__ void ph_gemm(const GemmArgs<NW>& g, const Epi& epi, LAS unsigned char* lds) {
    LAS float (*As)[68] = (LAS float (*)[68])lds;
    LAS float (*Ws)[128] = (LAS float (*)[128])(lds + 16 * 68 * 4);
    const int tid = threadIdx.x, tx = tid & 31, ty = tid >> 5;
    const int ntm = (g.Mrows + 63) / 64, ntn = (g.N + 127) / 128;
    for (int t = blockIdx.x; t < ntm * ntn; t += gridDim.x) {
        const int tm = t / ntn, tn = t % ntn;
        float acc[NW][4][4];
#pragma unroll
        for (int w = 0; w < NW; ++w)
#pragma unroll
            for (int i = 0; i < 4; ++i)
#pragma unroll
                for (int j = 0; j < 4; ++j) acc[w][i][j] = 0.f;
#pragma unroll
        for (int w = 0; w < NW; ++w) {
            for (int k0 = 0; k0 < g.K[w]; k0 += 16) {
                __syncthreads();
#pragma unroll
                for (int i = 0; i < 2; ++i) { const int e = tid + 512 * i, r = e >> 4, k = e & 15; const int row = tm * 64 + r;
                    As[k][r] = row < g.Mrows ? bf2f(g.A[w][(size_t)row * g.lda[w] + k0 + k]) : 0.f; }
#pragma unroll
                for (int i = 0; i < 4; ++i) { const int e = tid + 512 * i, k = e >> 7, c = e & 127; const int col = tn * 128 + c;
                    Ws[k][c] = col < g.N ? g.W[w][(size_t)(k0 + k) * g.N + col] : 0.f; }
                __syncthreads();
#pragma unroll
                for (int k = 0; k < 16; ++k) {
                    float a[4], b[4];
#pragma unroll
                    for (int i = 0; i < 4; ++i) a[i] = As[k][ty * 4 + i];
#pragma unroll
                    for (int j = 0; j < 4; ++j) b[j] = Ws[k][tx * 4 + j];
#pragma unroll
                    for (int i = 0; i < 4; ++i)
#pragma unroll
                        for (int j = 0; j < 4; ++j) acc[w][i][j] += a[i] * b[j];
                }
            }
        }
#pragma unroll
        for (int i = 0; i < 4; ++i)
#pragma unroll
            for (int j = 0; j < 4; ++j) {
                const int row = tm * 64 + ty * 4 + i, col = tn * 128 + tx * 4 + j;
                if (row < g.Mrows && col < g.N) {
                    if constexpr (NW == 1) epi(row, col, acc[0][i][j], 0.f, 0.f);
                    else if constexpr (NW == 2) epi(row, col, acc[0][i][j], acc[1][i][j], 0.f);
                    else epi(row, col, acc[0][i][j], acc[1][i][j], acc[2][i][j]);
                }
            }
    }
    __syncthreads();
}
struct EpiProj {
    bf16 *pr, *u, *gates; float* out;
    __device__ void operator()(int row, int col, float x, float, float) const {
        if (col < SHIFT) {
            pr[(size_t)row * SHIFT + col] = f2bf(x);
            if (row < MP) { if ((row % T) == T - 1) out[O_SHIFT_P + (size_t)(row / T) * SHIFT + col] = x; }
            else out[O_SHIFT_S + (size_t)(row - MP) * SHIFT + col] = x;
        } else if (col < SHIFT + 512) u[(size_t)row * 512 + (col - SHIFT)] = f2bf(x);
        else gates[(size_t)row * 2048 + (col - SHIFT - 512)] = f2bf(sigmoidf_(x));
    }
};
struct EpiMerge {
    const bf16* gates; const float *b1, *b2; bf16* merged;
    __device__ void operator()(int row, int col, float v0, float v1, float v2) const {
        const float ga = bf2f(gates[(size_t)row * 2048 + col]), gb = bf2f(gates[(size_t)row * 2048 + 1024 + col]);
        const float glu = (v1 + b1[col]) * sigmoidf_(v2 + b2[col]);
        merged[(size_t)row * D + col] = f2bf(ga * v0 + gb * glu);
    }
};
struct EpiF32 { float* o; int ld; __device__ void operator()(int row, int col, float v0, float, float) const { o[(size_t)row * ld + col] = v0; } };
struct EpiSwiglu { bf16* o; __device__ void operator()(int row, int col, float gt, float up, float) const { o[(size_t)row * FF + col] = f2bf(gt * sigmoidf_(gt) * up); } };

__device__ __forceinline__ void ph_rwkv_item(const P& p, LAS unsigned char* lds, int item) {
    LAS float (*lw)[64] = (LAS float (*)[64])lds;
    const int lane = threadIdx.x & 63, wv = threadIdx.x >> 6;
    const int seq = (item / NH) * NWAVES + wv, h = item % NH;
    const bool prompt = seq < NB;
    const int nT = prompt ? T : 1, row0 = prompt ? seq * T : MP + (seq - NB);
    const int ch = h * HN + lane;
    const bf16* pr = (const bf16*)(p.ws + WS_PR);
    bf16* oa = (bf16*)(p.ws + WS_OA);
    const float* mu = p.in[11];
    __syncthreads();
    if (wv == 0) {
        for (int j = 0; j < 32; ++j) { lw[j][lane] = p.in[13][(size_t)j * RW + ch]; lw[32 + j][lane] = p.in[15][(size_t)j * RW + ch]; }
        for (int j = 0; j < 64; ++j) lw[64 + j][lane] = p.in[16][(size_t)j * RW + ch];
    }
    __syncthreads();
    const float w0 = p.in[12][ch], a0 = p.in[14][ch], kk_w = p.in[17][ch], ka_w = p.in[18][ch], rk_w = p.in[19][ch], lng = p.in[20][ch], lnb = p.in[21][ch];
    const float mu_r = mu[ch], mu_k = mu[RW + ch], mu_v = mu[2 * RW + ch], mu_l1 = mu[3 * RW + lane], mu_l2 = mu[3 * RW + 64 + lane];
    float S[HN];
    float pr_r, pr_k, pr_v, pr_l1, pr_l2;
    if (prompt) {
#pragma unroll
        for (int k = 0; k < HN; ++k) S[k] = 0.f;
        pr_r = pr_k = pr_v = pr_l1 = pr_l2 = 0.f;
    } else {
        const int sb = seq - NB;
        const float* st = p.in[3] + ((size_t)sb * NH + h) * HN * HN + (size_t)lane * HN;
#pragma unroll
        for (int k = 0; k < HN; ++k) S[k] = st[k];
        const float* sh = p.in[2] + (size_t)sb * SHIFT;
        pr_r = sh[ch]; pr_k = sh[RW + ch]; pr_v = sh[2 * RW + ch]; pr_l1 = sh[3 * RW + lane]; pr_l2 = sh[3 * RW + 64 + lane];
    }
    for (int t = 0; t < nT; ++t) {
        const bf16* prow = pr + (size_t)(row0 + t) * SHIFT;
        const float c_r = bf2f(prow[ch]), c_k = bf2f(prow[RW + ch]), c_v = bf2f(prow[2 * RW + ch]), c_l1 = bf2f(prow[3 * RW + lane]), c_l2 = bf2f(prow[3 * RW + 64 + lane]);
        const float r = c_r + (pr_r - c_r) * mu_r, k = c_k + (pr_k - c_k) * mu_k, v = c_v + (pr_v - c_v) * mu_v;
        const float l1 = c_l1 + (pr_l1 - c_l1) * mu_l1, l2 = c_l2 + (pr_l2 - c_l2) * mu_l2;
        pr_r = c_r; pr_k = c_k; pr_v = c_v; pr_l1 = c_l1; pr_l2 = c_l2;
        const float in1 = lane < 32 ? tanhf(l1) : l1;
        const float in2 = sigmoidf_(l2);
        float sw = 0.f, sa_ = 0.f, sg = 0.f;
#pragma unroll 8
        for (int j = 0; j < 32; ++j) { sw += __shfl(in1, j) * lw[j][lane]; sa_ += __shfl(in1, 32 + j) * lw[32 + j][lane]; }
#pragma unroll 8
        for (int j = 0; j < 64; ++j) sg += __shfl(in2, j) * lw[64 + j][lane];
        const float z = -(w0 + sw);
        const float sp = fmaxf(z, 0.f) + log1pf(__expf(-fabsf(z)));
        const float wlog = -sp - 0.5f;
        const float dec = __expf(-__expf(wlog));
        const float a = sigmoidf_(a0 + sa_);
        const float g = sg;
        float kkv = k * kk_w;
        const float nrm = wave_sum(kkv * kkv);
        kkv = kkv * rsqrtf(fmaxf(nrm, 1e-24f));
        const float kp = k * (1.f + (a - 1.f) * ka_w);
        const float bv = kkv * a;
        float sa = 0.f;
#pragma unroll
        for (int kx = 0; kx < HN; ++kx) sa -= S[kx] * __shfl(kkv, kx);
        float o = 0.f;
#pragma unroll
        for (int kx = 0; kx < HN; ++kx) {
            S[kx] = S[kx] * __shfl(dec, kx) + sa * __shfl(bv, kx) + v * __shfl(kp, kx);
            o += S[kx] * __shfl(r, kx);
        }
        const float mean = wave_sum(o) * (1.f / HN);
        const float dlt = o - mean;
        const float var = wave_sum(dlt * dlt) * (1.f / HN);
        float on = dlt * rsqrtf(var + LNX_EPS) * lng + lnb;
        const float bonus = wave_sum(r * kp * rk_w) * v;
        on = (on + bonus) * g;
        oa[(size_t)(row0 + t) * RW + ch] = f2bf(on);
    }
    float* so = prompt ? p.out + O_WKV_P + ((size_t)seq * NH + h) * HN * HN : p.out + O_WKV_S + ((size_t)(seq - NB) * NH + h) * HN * HN;
#pragma unroll
    for (int k = 0; k < HN; ++k) so[(size_t)lane * HN + k] = S[k];
}

__device__ __forceinline__ float gelu_tanh(float x) { const float c = 0.7978845608028654f; return 0.5f * x * (1.f + tanhf(c * (x + 0.044715f * x * x * x))); }
__device__ __forceinline__ void ph_s5_item(const P& p, int item) {
    const int lane = threadIdx.x & 63;
    const int seq = item / SG, g = item % SG;
    const bool prompt = seq < NB;
    const int nT = prompt ? T : 1, row0 = prompt ? seq * T : MP + (seq - NB);
    const bf16* u = (const bf16*)(p.ws + WS_U);
    bf16* hgl = (bf16*)(p.ws + WS_HGL);
    const float lre = p.in[23][g * SP + lane], lim = p.in[24][g * SP + lane], dt = __expf(p.in[25][g]);
    const float mag = __expf(lre * dt), ang = lim * dt;
    const float lbr = mag * cosf(ang), lbi = mag * sinf(ang);
    const float nr = lbr - 1.f, ni = lbi, den = lre * lre + lim * lim;
    const float fre = (nr * lre + ni * lim) / den, fim = (ni * lre - nr * lim) / den;
    float bbr[SC], bbi[SC], cr[SC], ci[SC];
#pragma unroll
    for (int c = 0; c < SC; ++c) {
        const float br = p.in[26][((size_t)g * SP + lane) * SC + c], bi = p.in[27][((size_t)g * SP + lane) * SC + c];
        bbr[c] = fre * br - fim * bi; bbi[c] = fre * bi + fim * br;
        cr[c] = p.in[28][((size_t)g * SC + c) * SP + lane]; ci[c] = p.in[29][((size_t)g * SC + c) * SP + lane];
    }
    const float dsk = lane < SC ? p.in[30][g * SC + lane] : 0.f;
    float xr = 0.f, xi = 0.f;
    if (!prompt) { xr = p.in[4][((size_t)(seq - NB) * SG + g) * SP + lane]; xi = p.in[5][((size_t)(seq - NB) * SG + g) * SP + lane]; }
    for (int t = 0; t < nT; ++t) {
        const float uv = lane < SC ? bf2f(u[(size_t)(row0 + t) * 512 + g * SC + lane]) : 0.f;
        float bur = 0.f, bui = 0.f;
#pragma unroll
        for (int c = 0; c < SC; ++c) { const float uc = __shfl(uv, c); bur += bbr[c] * uc; bui += bbi[c] * uc; }
        const float nxr = lbr * xr - lbi * xi + bur, nxi = lbr * xi + lbi * xr + bui;
        xr = nxr; xi = nxi;
        float y = 0.f;
#pragma unroll
        for (int c = 0; c < SC; ++c) { const float s = wave_sum(cr[c] * xr - ci[c] * xi); if (lane == c) y = s; }
        if (lane < SC) { y += dsk * uv; hgl[(size_t)(row0 + t) * 512 + g * SC + lane] = f2bf(gelu_tanh(y)); }
    }
    float* ore = prompt ? p.out + O_S5RE_P + ((size_t)seq * SG + g) * SP : p.out + O_S5RE_S + ((size_t)(seq - NB) * SG + g) * SP;
    float* oim = prompt ? p.out + O_S5IM_P + ((size_t)seq * SG + g) * SP : p.out + O_S5IM_S + ((size_t)(seq - NB) * SG + g) * SP;
    ore[lane] = xr; oim[lane] = xi;
}

__device__ __forceinline__ void ph_row1(const P& p) {
    const int lane = threadIdx.x & 63, gw = blockIdx.x * NWAVES + (threadIdx.x >> 6), NGW = gridDim.x * NWAVES;
    const float *g1 = p.in[7], *g2 = p.in[8];
    const float* mix = (const float*)(p.ws + WS_MIX);
    bf16* h2 = (bf16*)(p.ws + WS_H2);
    for (int r = gw; r < M; r += NGW) {
        const float* x = xrow(p, r);
        float v[16]; float s = 0.f;
#pragma unroll
        for (int j = 0; j < 16; ++j) { v[j] = mix[(size_t)r * D + lane + 64 * j]; s += v[j] * v[j]; }
        s = wave_sum(s);
        const float rs = rsqrtf(s * (1.f / D) + NORM_EPS);
        float s2 = 0.f;
#pragma unroll
        for (int j = 0; j < 16; ++j) { v[j] = x[lane + 64 * j] + v[j] * rs * g1[lane + 64 * j]; s2 += v[j] * v[j]; }
        s2 = wave_sum(s2);
        const float rs2 = rsqrtf(s2 * (1.f / D) + NORM_EPS);
#pragma unroll
        for (int j = 0; j < 16; ++j) { p.out[(size_t)r * D + lane + 64 * j] = v[j]; h2[(size_t)r * D + lane + 64 * j] = f2bf(v[j] * rs2 * g2[lane + 64 * j]); }
    }
}
__device__ __forceinline__ void ph_row2(const P& p) {
    const int lane = threadIdx.x & 63, gw = blockIdx.x * NWAVES + (threadIdx.x >> 6), NGW = gridDim.x * NWAVES;
    const float* g3 = p.in[9];
    const float* f = (const float*)(p.ws + WS_F);
    for (int r = gw; r < M; r += NGW) {
        float v[16]; float s = 0.f;
#pragma unroll
        for (int j = 0; j < 16; ++j) { v[j] = f[(size_t)r * D + lane + 64 * j]; s += v[j] * v[j]; }
        s = wave_sum(s);
        const float rs = rsqrtf(s * (1.f / D) + NORM_EPS);
#pragma unroll
        for (int j = 0; j < 16; ++j) { const size_t i = (size_t)r * D + lane + 64 * j; p.out[i] = p.out[i] + v[j] * rs * g3[lane + 64 * j]; }
    }
}


namespace rk {
typedef short bf16x8 __attribute__((ext_vector_type(8)));
typedef unsigned u32x2 __attribute__((ext_vector_type(2)));
constexpr int LD = 72, SLOT = 64 * LD * 2;
constexpr int LDL = 136;
constexpr int LDF = 68;
constexpr int NCH = T / 64, NUNIT = NB * NCH * NH;
constexpr int F_OFF = 0, M_OFF = 3 * 64 * LDF * 4  , TOT_OFF = M_OFF + 8 * SLOT  ;
static_assert(TOT_OFF + 8 * 64 * 4 <= 131072, "rk lds map");
constexpr size_t WS_WT_LORA = 31 * MiB;
constexpr size_t WS_GT = 33 * MiB, WS_RT = 49 * MiB, WS_S0 = 201 * MiB, WS_CC = 251 * MiB;
constexpr size_t OB_QD = 0, OB_O1 = 16 * MiB, OB_G = 32 * MiB, OB_BV = 48 * MiB;

__device__ __forceinline__ LAS bf16* Fs(LAS unsigned char* lds, int i) { return (LAS bf16*)(lds + F_OFF + i * SLOT); }
__device__ __forceinline__ LAS bf16* Ms(LAS unsigned char* lds, int i) { return (LAS bf16*)(lds + M_OFF + i * SLOT); }
#define RK_BAR() do { asm volatile("s_waitcnt lgkmcnt(0)" ::: "memory"); __syncthreads(); } while (0)

template <int KS>
__device__ __forceinline__ void mm(const LAS bf16* X, int ldx, int kx0, const LAS bf16* Y, int ldy, int ky0, f32x4 (&acc)[2], int rb, int ch, int lane) {
    const int r16 = lane & 15, g = lane >> 4;
#pragma unroll
    for (int s = 0; s < KS; ++s) {
        const bf16x8 a = *(const LAS bf16x8*)(X + (16 * rb + r16) * ldx + kx0 + 32 * s + 8 * g);
#pragma unroll
        for (int j = 0; j < 2; ++j) {
            const bf16x8 b = *(const LAS bf16x8*)(Y + (16 * (2 * ch + j) + r16) * ldy + ky0 + 32 * s + 8 * g);
            acc[j] = __builtin_amdgcn_mfma_f32_16x16x32_bf16(a, b, acc[j], 0, 0, 0);
        }
    }
}
__device__ __forceinline__ void zero2(f32x4 (&a)[2]) { a[0] = (f32x4){0.f, 0.f, 0.f, 0.f}; a[1] = (f32x4){0.f, 0.f, 0.f, 0.f}; }
__device__ __forceinline__ void mask2(f32x4 (&a)[2], int mode, int rb, int ch, int lane) {
    const int c16 = lane & 15, g = lane >> 4;
#pragma unroll
    for (int j = 0; j < 2; ++j)
#pragma unroll
        for (int i = 0; i < 4; ++i) { const int row = 16 * rb + 4 * g + i, col = 16 * (2 * ch + j) + c16; const bool keep = mode == 1 ? col < row : col <= row; if (!keep) a[j][i] = 0.f; }
}
__device__ __forceinline__ void store_nat(LAS bf16* Mx, const f32x4 (&a)[2], int rb, int ch, int lane) {
    const int c16 = lane & 15, g = lane >> 4;
#pragma unroll
    for (int j = 0; j < 2; ++j)
#pragma unroll
        for (int i = 0; i < 4; ++i) Mx[(16 * rb + 4 * g + i) * LD + 16 * (2 * ch + j) + c16] = f2bf(a[j][i]);
}
__device__ __forceinline__ u32x2 pack4(const f32x4& v) { u32x2 w; w.x = pg8::cvt_pk_bf16(v[0], v[1]); w.y = pg8::cvt_pk_bf16(v[2], v[3]); return w; }
__device__ __forceinline__ f32x4 unpack4(const u32x2& w) { f32x4 v; v[0] = __uint_as_float(w.x << 16); v[1] = __uint_as_float(w.x & 0xffff0000u); v[2] = __uint_as_float(w.y << 16); v[3] = __uint_as_float(w.y & 0xffff0000u); return v; }
__device__ __forceinline__ void store_tr(LAS bf16* Mx, const f32x4 (&a)[2], int rb, int ch, int lane) {
    const int c16 = lane & 15, g = lane >> 4;
#pragma unroll
    for (int j = 0; j < 2; ++j) *(LAS u32x2*)(Mx + (16 * (2 * ch + j) + c16) * LD + 16 * rb + 4 * g) = pack4(a[j]);
}
__device__ __forceinline__ void add_nat(const LAS bf16* Mx, f32x4 (&a)[2], int rb, int ch, int lane) {
    const int c16 = lane & 15, g = lane >> 4;
#pragma unroll
    for (int j = 0; j < 2; ++j)
#pragma unroll
        for (int i = 0; i < 4; ++i) a[j][i] += bf2f(Mx[(16 * rb + 4 * g + i) * LD + 16 * (2 * ch + j) + c16]);
}
__device__ __forceinline__ void store_f32(LAS float* Fx, const f32x4 (&a)[2], int rb, int ch, int lane) {
    const int c16 = lane & 15, g = lane >> 4;
#pragma unroll
    for (int j = 0; j < 2; ++j)
#pragma unroll
        for (int i = 0; i < 4; ++i) Fx[(16 * rb + 4 * g + i) * LDF + 16 * (2 * ch + j) + c16] = a[j][i];
}
__device__ __forceinline__ void dump2(unsigned char* base, int unit, const f32x4 (&a)[2], int wv, int lane) {
    u32x2* d = (u32x2*)(base + (size_t)unit * 8192) + (wv * 2) * 64 + lane;
    d[0] = pack4(a[0]); d[64] = pack4(a[1]);
}
__device__ __forceinline__ void undump2(const unsigned char* base, int unit, f32x4 (&a)[2], int wv, int lane) {
    const u32x2* d = (const u32x2*)(base + (size_t)unit * 8192) + (wv * 2) * 64 + lane;
    a[0] = unpack4(d[0]); a[1] = unpack4(d[64]);
}
__device__ __forceinline__ void copy_out(const LAS bf16* Mx, bf16* gl) { const int r = threadIdx.x >> 3, c8 = (threadIdx.x & 7) * 8; *(u32x4*)(gl + r * 64 + c8) = *(const LAS u32x4*)(Mx + r * LD + c8); }
__device__ __forceinline__ void copy_in(LAS bf16* Mx, const bf16* gl) { const int r = threadIdx.x >> 3, c8 = (threadIdx.x & 7) * 8; *(LAS u32x4*)(Mx + r * LD + c8) = *(const u32x4*)(gl + r * 64 + c8); }

__device__ __forceinline__ void prep_unit(const P& p, LAS unsigned char* lds, int unit) {
    const int tid = threadIdx.x, lane = tid & 63, wv = tid >> 6, rb = wv & 3, ch = wv >> 2;
    const int h = unit & 7, bc = unit >> 3, c = bc & (NCH - 1), b = bc / NCH, row0 = b * T + c * 64;
    const bf16* PRb = (const bf16*)(p.ws + WS_PR);
    unsigned char* ob = (unsigned char*)p.out;
    LAS float* FW = (LAS float*)(lds + F_OFF); LAS float* FA = FW + 64 * LDF; LAS float* FG = FA + 64 * LDF;
    LAS bf16* LIN = (LAS bf16*)(lds + M_OFF); LAS bf16* WL = (LAS bf16*)(lds + M_OFF + 2 * SLOT);
    LAS float* TOT = (LAS float*)(lds + TOT_OFF);
    const float* mu = p.in[11];
    const bool first = (c == 0 && wv == 0);
    {
        const bf16* prl = PRb + (size_t)(row0 + 8 * wv) * SHIFT + 3 * RW;
        const float mu0 = mu[3 * RW + lane], mu1 = mu[3 * RW + 64 + lane];
        float p0 = first ? 0.f : bf2f(prl[-SHIFT + lane]), p1 = first ? 0.f : bf2f(prl[-SHIFT + 64 + lane]);
#pragma unroll
        for (int i = 0; i < 8; ++i) {
            const float c0 = bf2f(prl[i * SHIFT + lane]), c1 = bf2f(prl[i * SHIFT + 64 + lane]);
            const float x0 = c0 + (p0 - c0) * mu0, x1 = c1 + (p1 - c1) * mu1; p0 = c0; p1 = c1;
            LIN[(8 * wv + i) * LDL + lane] = f2bf(lane < 32 ? tanhf(x0) : x0);
            LIN[(8 * wv + i) * LDL + 64 + lane] = f2bf(sigmoidf_(x1));
        }
        const bf16* wl = (const bf16*)(p.ws + WS_WT_LORA) + (size_t)(h * 64 + (tid >> 3)) * 128 + (tid & 7) * 16;
        *(LAS u32x4*)(WL + (tid >> 3) * LDL + (tid & 7) * 16) = *(const u32x4*)wl;
        *(LAS u32x4*)(WL + (tid >> 3) * LDL + (tid & 7) * 16 + 8) = *(const u32x4*)(wl + 8);
    }
    RK_BAR();
    {
        f32x4 aw[2], aa[2], ag[2]; zero2(aw); zero2(aa); zero2(ag);
        mm<1>(LIN, LDL, 0, WL, LDL, 0, aw, rb, ch, lane);
        mm<1>(LIN, LDL, 32, WL, LDL, 32, aa, rb, ch, lane);
        mm<2>(LIN, LDL, 64, WL, LDL, 64, ag, rb, ch, lane);
        store_f32(FW, aw, rb, ch, lane); store_f32(FA, aa, rb, ch, lane); store_f32(FG, ag, rb, ch, lane);
    }
    RK_BAR();
    {
        const int cg = h * 64 + lane;
        const float w0 = p.in[12][cg], a0 = p.in[14][cg], kkw = p.in[17][cg], kaw = p.in[18][cg], rkw = p.in[19][cg];
        const float mur = mu[cg], muk = mu[RW + cg], muv = mu[2 * RW + cg];
        const bf16* pr = PRb + (size_t)(row0 + 8 * wv) * SHIFT + cg;
        float pr_r = first ? 0.f : bf2f(pr[-SHIFT]), pr_k = first ? 0.f : bf2f(pr[-SHIFT + RW]), pr_v = first ? 0.f : bf2f(pr[-SHIFT + 2 * RW]);
        float rr[8], kp[8], vv[8], kkv[8], bv[8], ld[8];
        bf16* gout = (bf16*)(ob + OB_G) + (size_t)(row0 + 8 * wv) * RW + cg;
        bf16* bvout = (bf16*)(ob + OB_BV) + (size_t)(row0 + 8 * wv) * RW + cg;
        float run = 0.f;
#pragma unroll
        for (int i = 0; i < 8; ++i) {
            const int row = 8 * wv + i;
            const float c_r = bf2f(pr[i * SHIFT]), c_k = bf2f(pr[i * SHIFT + RW]), c_v = bf2f(pr[i * SHIFT + 2 * RW]);
            const float r_ = c_r + (pr_r - c_r) * mur, k_ = c_k + (pr_k - c_k) * muk, v_ = c_v + (pr_v - c_v) * muv;
            pr_r = c_r; pr_k = c_k; pr_v = c_v;
            const float z = -(w0 + FW[row * LDF + lane]);
            const float sp = fmaxf(z, 0.f) + log1pf(__expf(-fabsf(z)));
            const float l_ = -__expf(-sp - 0.5f);
            const float a_ = sigmoidf_(a0 + FA[row * LDF + lane]);
            float kk_ = k_ * kkw;
            const float nrm = wave_sum(kk_ * kk_);
            kk_ *= rsqrtf(fmaxf(nrm, 1e-24f));
            const float kp_ = k_ * (1.f + (a_ - 1.f) * kaw);
            const float bonus = wave_sum(r_ * kp_ * rkw);
            gout[(size_t)i * RW] = f2bf(FG[row * LDF + lane]);
            bvout[(size_t)i * RW] = f2bf(bonus * v_);
            run += l_;
            rr[i] = r_; kp[i] = kp_; vv[i] = v_; kkv[i] = kk_; bv[i] = kk_ * a_; ld[i] = run;
        }
        TOT[wv * 64 + lane] = run;
        RK_BAR();
        float off = 0.f, tot = 0.f;
#pragma unroll
        for (int w2 = 0; w2 < 8; ++w2) { const float t_ = TOT[w2 * 64 + lane]; tot += t_; if (w2 < wv) off += t_; }
        if (wv == 0) ((float*)(p.ws + WS_CC))[(size_t)unit * 64 + lane] = __expf(tot);
        LAS bf16 *mA = Ms(lds, 0), *mB = Ms(lds, 1), *mK = Ms(lds, 2), *mR = Ms(lds, 3), *mAT = Ms(lds, 4), *mVT = Ms(lds, 5), *mBT = Ms(lds, 6), *mKT = Ms(lds, 7);
        float at[8], vt[8], bt[8], kt[8];
        float prevcl = off;
#pragma unroll
        for (int i = 0; i < 8; ++i) {
            const int row = 8 * wv + i;
            const float cl = off + ld[i];
            const float e_prev = __expf(prevcl), e_neg = __expf(-cl), e_pos = __expf(cl), e_rel = __expf(tot - cl);
            prevcl = cl;
            const float A_ = -kkv[i] * e_prev, B_ = bv[i] * e_neg, K_ = kp[i] * e_neg, R_ = rr[i] * e_pos;
            mA[row * LD + lane] = f2bf(A_); mB[row * LD + lane] = f2bf(B_); mK[row * LD + lane] = f2bf(K_); mR[row * LD + lane] = f2bf(R_);
            at[i] = A_; vt[i] = vv[i]; bt[i] = bv[i] * e_rel; kt[i] = kp[i] * e_rel;
        }
        u32x4 w_;
        w_.x = pg8::cvt_pk_bf16(at[0], at[1]); w_.y = pg8::cvt_pk_bf16(at[2], at[3]); w_.z = pg8::cvt_pk_bf16(at[4], at[5]); w_.w = pg8::cvt_pk_bf16(at[6], at[7]); *(LAS u32x4*)(mAT + lane * LD + 8 * wv) = w_;
        w_.x = pg8::cvt_pk_bf16(vt[0], vt[1]); w_.y = pg8::cvt_pk_bf16(vt[2], vt[3]); w_.z = pg8::cvt_pk_bf16(vt[4], vt[5]); w_.w = pg8::cvt_pk_bf16(vt[6], vt[7]); *(LAS u32x4*)(mVT + lane * LD + 8 * wv) = w_;
        w_.x = pg8::cvt_pk_bf16(bt[0], bt[1]); w_.y = pg8::cvt_pk_bf16(bt[2], bt[3]); w_.z = pg8::cvt_pk_bf16(bt[4], bt[5]); w_.w = pg8::cvt_pk_bf16(bt[6], bt[7]); *(LAS u32x4*)(mBT + lane * LD + 8 * wv) = w_;
        w_.x = pg8::cvt_pk_bf16(kt[0], kt[1]); w_.y = pg8::cvt_pk_bf16(kt[2], kt[3]); w_.z = pg8::cvt_pk_bf16(kt[4], kt[5]); w_.w = pg8::cvt_pk_bf16(kt[6], kt[7]); *(LAS u32x4*)(mKT + lane * LD + 8 * wv) = w_;
    }
    RK_BAR();
    LAS bf16 *mA = Ms(lds, 0), *mB = Ms(lds, 1), *mK = Ms(lds, 2), *mR = Ms(lds, 3), *mAT = Ms(lds, 4), *mVT = Ms(lds, 5), *mBT = Ms(lds, 6), *mKT = Ms(lds, 7);
    f32x4 accQ[2], accN[2], accX[2], accO[2], accS[2], t_[2];
    zero2(accQ); mm<2>(mKT, LD, 0, mVT, LD, 0, accQ, rb, ch, lane);
    zero2(accN); mm<2>(mA, LD, 0, mB, LD, 0, accN, rb, ch, lane); mask2(accN, 1, rb, ch, lane); store_nat(Fs(lds, 0), accN, rb, ch, lane); store_tr(Fs(lds, 1), accN, rb, ch, lane);
    zero2(t_); mm<2>(mA, LD, 0, mK, LD, 0, t_, rb, ch, lane); mask2(t_, 1, rb, ch, lane); store_nat(Fs(lds, 2), t_, rb, ch, lane);
    zero2(t_); mm<2>(mR, LD, 0, mB, LD, 0, t_, rb, ch, lane); mask2(t_, 2, rb, ch, lane); store_nat(Fs(lds, 3), t_, rb, ch, lane);
    zero2(t_); mm<2>(mR, LD, 0, mK, LD, 0, t_, rb, ch, lane); mask2(t_, 2, rb, ch, lane); store_nat(Fs(lds, 4), t_, rb, ch, lane);
    RK_BAR();
    zero2(accS); mm<2>(Fs(lds, 0), LD, 0, Fs(lds, 1), LD, 0, accS, rb, ch, lane); store_nat(mB  , accS, rb, ch, lane); store_tr(mK  , accS, rb, ch, lane);
    zero2(accX); mm<2>(Fs(lds, 2), LD, 0, mVT, LD, 0, accX, rb, ch, lane); store_tr(mKT  , accX, rb, ch, lane);
    zero2(accO); mm<2>(Fs(lds, 4), LD, 0, mVT, LD, 0, accO, rb, ch, lane);
    RK_BAR();
#define RK_NEUMANN(Ncur, Qcur, QTcur, Nnext, Qnext, QTnext, SQUARE) do { \
        accN[0] += accS[0]; accN[1] += accS[1]; mm<2>(Ncur, LD, 0, QTcur, LD, 0, accN, rb, ch, lane); store_nat(Nnext, accN, rb, ch, lane); \
        if (SQUARE) { zero2(t_); mm<2>(Qcur, LD, 0, QTcur, LD, 0, t_, rb, ch, lane); accS[0] = t_[0]; accS[1] = t_[1]; store_nat(Qnext, accS, rb, ch, lane); store_tr(QTnext, accS, rb, ch, lane); } \
        RK_BAR(); } while (0)
    RK_NEUMANN(Fs(lds, 0), mB, mK, Fs(lds, 2), Fs(lds, 4), mVT, true);
    RK_NEUMANN(Fs(lds, 2), Fs(lds, 4), mVT, Fs(lds, 1), mB, mK, true);
    RK_NEUMANN(Fs(lds, 1), mB, mK, Fs(lds, 2), Fs(lds, 4), mVT, true);
    RK_NEUMANN(Fs(lds, 2), Fs(lds, 4), mVT, Fs(lds, 1), mB, mK, true);
    RK_NEUMANN(Fs(lds, 1), mB, mK, Fs(lds, 2), Fs(lds, 4), mVT, false);
#undef RK_NEUMANN
    zero2(t_); mm<2>(Fs(lds, 2), LD, 0, mAT, LD, 0, t_, rb, ch, lane); add_nat(mA, t_, rb, ch, lane); store_tr(Fs(lds, 0), t_, rb, ch, lane);
    mm<2>(Fs(lds, 2), LD, 0, mKT, LD, 0, accX, rb, ch, lane); store_tr(mB  , accX, rb, ch, lane);
    RK_BAR();
    zero2(t_); mm<2>(Fs(lds, 0), LD, 0, mBT, LD, 0, t_, rb, ch, lane); store_tr(mK  , t_, rb, ch, lane);
    mm<2>(mBT, LD, 0, mB  , LD, 0, accQ, rb, ch, lane);
    zero2(t_); mm<2>(Fs(lds, 3), LD, 0, Fs(lds, 0), LD, 0, t_, rb, ch, lane); add_nat(mR, t_, rb, ch, lane); store_nat(mVT  , t_, rb, ch, lane);
    mm<2>(Fs(lds, 3), LD, 0, mB  , LD, 0, accO, rb, ch, lane);
    dump2(ob + OB_QD, unit, accQ, wv, lane); dump2(ob + OB_O1, unit, accO, wv, lane);
    RK_BAR();
    copy_out(mK, (bf16*)(p.ws + WS_GT) + (size_t)unit * 4096);
    copy_out(mVT, (bf16*)(p.ws + WS_RT) + (size_t)unit * 4096);
    RK_BAR();
}

__device__ __forceinline__ void scan_seq(const P& p, LAS unsigned char* lds, int bh) {
    const int tid = threadIdx.x, lane = tid & 63, wv = tid >> 6, rb = wv & 3, ch = wv >> 2, g = lane >> 4;
    const int b = bh >> 3, h = bh & 7;
    LAS bf16* mS = (LAS bf16*)lds;
    LAS bf16* mG[2] = {(LAS bf16*)(lds + SLOT), (LAS bf16*)(lds + 2 * SLOT)};
    const unsigned char* ob = (const unsigned char*)p.out;
    f32x4 acc[2]; zero2(acc);
    store_tr(mS, acc, rb, ch, lane);
    copy_in(mG[0], (const bf16*)(p.ws + WS_GT) + (size_t)((b * NCH) * 8 + h) * 4096);
    RK_BAR();
    for (int n = 0; n < NCH; ++n) {
        const int unit = (b * NCH + n) * 8 + h;
        copy_out(mS, (bf16*)(p.ws + WS_S0) + (size_t)unit * 4096);
        if (n + 1 < NCH) copy_in(mG[(n + 1) & 1], (const bf16*)(p.ws + WS_GT) + (size_t)(unit + 8) * 4096);
        const float* cc = (const float*)(p.ws + WS_CC) + (size_t)unit * 64 + 16 * rb + 4 * g;
        const f32x4 cv = *(const f32x4*)cc;
        f32x4 q[2]; undump2(ob + OB_QD, unit, q, wv, lane);
        acc[0] = acc[0] * cv + q[0]; acc[1] = acc[1] * cv + q[1];
        mm<2>(mG[n & 1], LD, 0, mS, LD, 0, acc, rb, ch, lane);
        RK_BAR();
        store_tr(mS, acc, rb, ch, lane);
        RK_BAR();
    }
    float* so = p.out + O_WKV_P + (size_t)bh * 4096;
#pragma unroll
    for (int j = 0; j < 2; ++j) *(f32x4*)(so + (16 * (2 * ch + j) + (lane & 15)) * 64 + 16 * rb + 4 * g) = acc[j];
}

__device__ __forceinline__ void out_unit(const P& p, LAS unsigned char* lds, int unit) {
    const int tid = threadIdx.x, lane = tid & 63, wv = tid >> 6, rb = wv & 3, ch = wv >> 2;
    const int h = unit & 7, bc = unit >> 3, c = bc & (NCH - 1), b = bc / NCH, row0 = b * T + c * 64;
    LAS bf16* mR = (LAS bf16*)lds; LAS bf16* mS = (LAS bf16*)(lds + SLOT); LAS float* OF = (LAS float*)(lds + 2 * SLOT);
    const unsigned char* ob = (const unsigned char*)p.out;
    copy_in(mR, (const bf16*)(p.ws + WS_RT) + (size_t)unit * 4096);
    copy_in(mS, (const bf16*)(p.ws + WS_S0) + (size_t)unit * 4096);
    f32x4 acc[2]; undump2(ob + OB_O1, unit, acc, wv, lane);
    RK_BAR();
    mm<2>(mR, LD, 0, mS, LD, 0, acc, rb, ch, lane);
    store_f32(OF, acc, rb, ch, lane);
    RK_BAR();
    const int cg = h * 64 + lane;
    const float lng = p.in[20][cg], lnb = p.in[21][cg];
    const bf16* gin = (const bf16*)(ob + OB_G) + (size_t)(row0 + 8 * wv) * RW + cg;
    const bf16* bvin = (const bf16*)(ob + OB_BV) + (size_t)(row0 + 8 * wv) * RW + cg;
    bf16* oa = (bf16*)(p.ws + WS_OA) + (size_t)(row0 + 8 * wv) * RW + cg;
#pragma unroll
    for (int i = 0; i < 8; ++i) {
        const float o = OF[(8 * wv + i) * LDF + lane];
        const float mean = wave_sum(o) * (1.f / 64.f);
        const float d = o - mean;
        const float var = wave_sum(d * d) * (1.f / 64.f);
        const float on = d * rsqrtf(var + LNX_EPS) * lng + lnb;
        oa[(size_t)i * RW] = f2bf((on + bf2f(bvin[(size_t)i * RW])) * bf2f(gin[(size_t)i * RW]));
    }
    RK_BAR();
}
__device__ __forceinline__ void lora_transpose(const P& p) {
    bf16* wl = (bf16*)(p.ws + WS_WT_LORA);
    for (int e = blockIdx.x * NTHR + threadIdx.x; e < 512 * 128; e += gridDim.x * NTHR) {
        const int chn = e >> 7, j = e & 127;
        const float v = j < 32 ? p.in[13][(size_t)j * RW + chn] : j < 64 ? p.in[15][(size_t)(j - 32) * RW + chn] : p.in[16][(size_t)(j - 64) * RW + chn];
        wl[e] = f2bf(v);
    }
}
}

constexpr int N_PHASES = 12;
__global__ void __launch_bounds__(NTHR, 2) mk_fwd(P p) {
    extern __shared__ __attribute__((aligned(16))) unsigned char lds_raw[];
    LAS unsigned char* lds = (LAS unsigned char*)lds_raw;
    volatile LAS unsigned* MISC = (volatile LAS unsigned*)(lds + MISC_OFF);
    for (int u = threadIdx.x; u < (LDS_BYTES - 131072) / 4; u += NTHR) ((LAS unsigned*)(lds + 131072))[u] = 0u;
    __syncthreads();
    unsigned* ctl = (unsigned*)(p.ws + WS_CTL);
    XcdBarrier bar = xcd_barrier_post(ctl + CW_BAR, MISC + 8);
    const int lo = p.ph_lo, hi = p.ph_hi;
    unsigned char* ws = p.ws;
#define IN(k) (lo <= (k) && (k) < hi)
#define SEAM(k) do { if (IN(k) && IN((k) + 1)) xcd_barrier(bar); } while (0)
    if (IN(0)) { ph_prologue(p, lds); rk::lora_transpose(p); ph_xnorm(p); }
    SEAM(0);
    if (IN(1)) { EpiProjM e{(bf16*)(ws + WS_PR), (bf16*)(ws + WS_U), (bf16*)(ws + WS_GATES), p.out};
        ph_mfma_gemm(lds, (const bf16*)(ws + WS_XN), (const bf16*)(ws + WS_WT_IN), 4352, 1024, e); }
    SEAM(1);
    if (IN(2)) {
        for (int unit = blockIdx.x; unit < rk::NUNIT; unit += gridDim.x) rk::prep_unit(p, lds, unit);
        for (int item = NH + blockIdx.x; item < ((NB + NS) / NWAVES) * NH; item += gridDim.x) ph_rwkv_item(p, lds, item);
        const int gw = blockIdx.x * NWAVES + (threadIdx.x >> 6), NGW = gridDim.x * NWAVES;
        for (int it = (gw + NGW / 2) % NGW; it < (NB + NS) * SG; it += NGW) ph_s5_item(p, it);
    }
    SEAM(2);
    if (IN(3)) { if (blockIdx.x < NB * NH) rk::scan_seq(p, lds, blockIdx.x); }
    SEAM(3);
    if (IN(4)) { for (int unit = blockIdx.x; unit < rk::NUNIT; unit += gridDim.x) rk::out_unit(p, lds, unit); }
    SEAM(4);
    if (IN(5)) { EpiA1M e{(const bf16*)(ws + WS_GATES), (bf16*)(ws + WS_MERGED)};
        ph_mfma_gemm(lds, (const bf16*)(ws + WS_OA), (const bf16*)(ws + WS_WT_RO), 1024, 512, e); }
    SEAM(5);
    if (IN(6)) { EpiGluM e{(const bf16*)(ws + WS_GATES), p.in[32], p.in[34], (bf16*)(ws + WS_MERGED)};
        ph_mfma_gemm(lds, (const bf16*)(ws + WS_HGL), (const bf16*)(ws + WS_WT_GLU), 2048, 512, e); }
    SEAM(6);
    if (IN(7)) { EpiF32M e{(float*)(ws + WS_MIX), D};
        ph_mfma_gemm(lds, (const bf16*)(ws + WS_MERGED), (const bf16*)(ws + WS_WT_MO), 1024, 1024, e); }
    SEAM(7);
    if (IN(8)) ph_row1(p);
    SEAM(8);
    if (IN(9)) { EpiSwigluM e{(bf16*)(ws + WS_HFF)};
        ph_mfma_gemm(lds, (const bf16*)(ws + WS_H2), (const bf16*)(ws + WS_WT_GU), 5632, 1024, e); }
    SEAM(9);
    if (IN(10)) { EpiF32M e{(float*)(ws + WS_F), D};
        ph_mfma_gemm(lds, (const bf16*)(ws + WS_HFF), (const bf16*)(ws + WS_WT_DN), 1024, FF, e); }
    SEAM(10);
    if (IN(11)) ph_row2(p);
#undef IN
#undef SEAM
}

#ifndef MK_N_LAUNCHES
#define MK_N_LAUNCHES 1
#endif
extern "C" void kernel_launch(void* const* d_in, const int* in_sizes, int n_in, void* d_out, int out_size, void* d_ws, size_t ws_size, hipStream_t stream) {
    static int grid = 0;
    if (grid == 0) {
        if (n_in != 39 || out_size != (int)O_END || ws_size < 256 * MiB) { fprintf(stderr, "kernel_launch: unexpected sizes n_in %d out %d ws %zu\n", n_in, out_size, ws_size); grid = -1; return; }
        int dev = 0, cus = 0;
        if (hipGetDevice(&dev) != hipSuccess || hipDeviceGetAttribute(&cus, hipDeviceAttributeMultiprocessorCount, dev) != hipSuccess) { grid = -1; return; }
        if (hipFuncSetAttribute((const void*)mk_fwd, hipFuncAttributeMaxDynamicSharedMemorySize, LDS_BYTES) != hipSuccess) { fprintf(stderr, "kernel_launch: hipFuncSetAttribute failed\n"); grid = -1; return; }
        grid = cus;
    }
    if (grid < 0) return;
    if (hipMemsetAsync((char*)d_ws + WS_CTL, 0, CTL_ZERO_BYTES, stream) != hipSuccess) return;
    P p{};
    for (int i = 0; i < 39; ++i) p.in[i] = (const float*)d_in[i];
    p.out = (float*)d_out; p.ws = (unsigned char*)d_ws;
    if (MK_N_LAUNCHES == 1) { p.ph_lo = 0; p.ph_hi = N_PHASES; hipLaunchKernelGGL(mk_fwd, dim3(grid), dim3(NTHR), LDS_BYTES, stream, p); }
    else for (int k = 0; k < N_PHASES; ++k) { p.ph_lo = k; p.ph_hi = k + 1; hipLaunchKernelGGL(mk_fwd, dim3(grid), dim3(NTHR), LDS_BYTES, stream, p); }
}
```

```cpp
#include <hip/hip_runtime.h>
#include <cstdint>
#include <cstdio>

constexpr int D = 1024, NB = 8, T = 2048, NS = 128;
constexpr int MP = NB * T;
constexpr int M = MP + NS;
constexpr int RW = 512, HN = 64, NH = 8;
constexpr int SHIFT = 1664, PROJ = 4224;
constexpr int SG = 32, SP = 64, SC = 16;
constexpr int FF = 2816;
constexpr float NORM_EPS = 1e-6f, LNX_EPS = 64e-5f;

typedef unsigned short bf16;
__device__ __forceinline__ float bf2f(bf16 v) { return __uint_as_float((unsigned)v << 16); }
__device__ __forceinline__ bf16 f2bf(float f) { unsigned u = __float_as_uint(f); return (bf16)((u + 0x7fffu + ((u >> 16) & 1u)) >> 16); }
__device__ __forceinline__ float wave_sum(float v) {
#pragma unroll
    for (int o = 1; o < 64; o <<= 1) v += __shfl_xor(v, o);
    return v;
}
__device__ __forceinline__ float sigmoidf_(float x) { return 1.f / (1.f + __expf(-x)); }

constexpr size_t O_Y = 0;
constexpr size_t O_SHIFT_P = (size_t)M * D;
constexpr size_t O_WKV_P = O_SHIFT_P + (size_t)NB * SHIFT;
constexpr size_t O_S5RE_P = O_WKV_P + (size_t)NB * NH * HN * HN;
constexpr size_t O_S5IM_P = O_S5RE_P + (size_t)NB * SG * SP;
constexpr size_t O_SHIFT_S = O_S5IM_P + (size_t)NB * SG * SP;
constexpr size_t O_WKV_S = O_SHIFT_S + (size_t)NS * SHIFT;
constexpr size_t O_S5RE_S = O_WKV_S + (size_t)NS * NH * HN * HN;
constexpr size_t O_S5IM_S = O_S5RE_S + (size_t)NS * SG * SP;
constexpr size_t O_END = O_S5IM_S + (size_t)NS * SG * SP;
static_assert(O_END == 22148096, "d_out size");

constexpr size_t MiB = 1u << 20;
constexpr int MPAD = 16640;
constexpr size_t WS_WT_IN = 1 * MiB;
constexpr size_t WS_WT_RO = WS_WT_IN + 4352 * 1024 * 2;
constexpr size_t WS_WT_GLU = WS_WT_RO + 1024 * 512 * 2;
constexpr size_t WS_WT_MO = WS_WT_GLU + 2048 * 512 * 2;
constexpr size_t WS_WT_GU = WS_WT_MO + 1024 * 1024 * 2;
constexpr size_t WS_WT_DN = WS_WT_GU + 5632 * 1024 * 2;
static_assert(WS_WT_DN + 1024 * 2816 * 2 <= 33 * MiB, "weights region");
constexpr size_t WS_XN = 33 * MiB;
constexpr size_t WS_PR = 66 * MiB;
constexpr size_t WS_U_UNUSED = 119 * MiB;
constexpr size_t WS_GATES = 139 * MiB;
constexpr size_t WS_OA = 220 * MiB;
constexpr size_t WS_HGL = 237 * MiB;
constexpr size_t WS_MERGED = WS_XN;
constexpr size_t WS_MIX = WS_PR;
constexpr size_t WS_H2 = WS_XN;
constexpr size_t WS_HFF = WS_PR;
constexpr size_t WS_F = 156 * MiB;

struct P {
    const float* in[39];
    float* out;
    unsigned char* ws;
    int ph_lo, ph_hi;
};
constexpr int NWAVES = 8, NTHR = NWAVES * 64;
constexpr int LDS_BYTES = 147456, MISC_OFF = 131072 + 320;
#define LAS __attribute__((address_space(3)))
constexpr size_t WS_CTL = 0, CTL_ZERO_BYTES = 1 * MiB;
constexpr int CW_BAR = 4096;

__device__ __forceinline__ const float* xrow(const P& p, int r) { return r < MP ? p.in[0] + (size_t)r * D : p.in[1] + (size_t)(r - MP) * D; }


#define XB_TMO      128
#define XB_XCNT(j)  (256  + 64 * (j))
#define XB_XSUB(j)  (1280 + 64 * (j))
#define XB_XGEN(j)  (2304 + 64 * (j))
#define XB_TOP      3328
#define XB_TOPGEN   3392
#define XCD_BAR_WORDS 3456
#define XB_SPIN_CAP (1u << 18)
__device__ __forceinline__ unsigned xb_ld(unsigned* p)              { return __hip_atomic_load(p, __ATOMIC_RELAXED, __HIP_MEMORY_SCOPE_AGENT); }
__device__ __forceinline__ unsigned xb_add(unsigned* p, unsigned v) { return __hip_atomic_fetch_add(p, v, __ATOMIC_RELAXED, __HIP_MEMORY_SCOPE_AGENT); }
__device__ __forceinline__ unsigned xb_xcc_id() { return (unsigned)__builtin_amdgcn_s_getreg((3 << 11) | 20) & 0xFu; }
#define XB_SPIN(cond, bar) do { unsigned _sp = 0; while (cond) { __builtin_amdgcn_s_sleep(1); \
    if ((++_sp & 255u) == 0u) { if (xb_ld(&(bar)[XB_TMO])) break; if (_sp > XB_SPIN_CAP) { atomicAdd(&(bar)[XB_TMO], 1u); break; } } } } while (0)
struct XcdBarrier { unsigned* bar; unsigned x; volatile LAS unsigned* st; };
__device__ __forceinline__ XcdBarrier xcd_barrier_post(unsigned* bar, volatile LAS unsigned* st) {
    XcdBarrier b; b.bar = bar; b.x = xb_xcc_id(); b.st = st;
    if (threadIdx.x == 0) (void)xb_add(&bar[XB_XCNT(b.x)], 1u);
    return b;
}
__device__ __forceinline__ void xcd_barrier_complete(unsigned* bar, unsigned x, unsigned& nloc, unsigned& nx) {
    const unsigned G = gridDim.x * gridDim.y * gridDim.z;
    unsigned sum, cnt, mine, sp = 0u;
    for (;;) {
        sum = 0u; cnt = 0u; mine = 0u;
#pragma unroll
        for (unsigned j = 0; j < 16; ++j) { const unsigned c = xb_ld(&bar[XB_XCNT(j)]); sum += c; cnt += (c > 0u) ? 1u : 0u; mine = (j == x) ? c : mine; }
        if (sum == G) break;
        __builtin_amdgcn_s_sleep(1);
        if ((++sp & 255u) == 0u) { if (xb_ld(&bar[XB_TMO])) break; if (sp > XB_SPIN_CAP) { atomicAdd(&bar[XB_TMO], 1u); break; } }
    }
    nloc = mine > 0u ? mine : 1u; nx = cnt > 0u ? cnt : 1u;
}
__device__ __forceinline__ void xcd_barrier(const XcdBarrier& b) {
    asm volatile("s_waitcnt vmcnt(0)" ::: "memory");
    __syncthreads();
    if (threadIdx.x == 0) {
        unsigned* bar = b.bar;
        __builtin_amdgcn_s_waitcnt(0);
        unsigned nloc = b.st[0], nx = b.st[1];
        if (nloc == 0u) { xcd_barrier_complete(bar, b.x, nloc, nx); b.st[0] = nloc; b.st[1] = nx; }
        const unsigned old = xb_add(&bar[XB_XSUB(b.x)], 1u);
        const unsigned gen = old / nloc;
        if (old + 1u == (gen + 1u) * nloc) {
            __builtin_amdgcn_fence(__ATOMIC_RELEASE, "agent");
            asm volatile("s_waitcnt vmcnt(0)" ::: "memory");
            const unsigned og = xb_add(&bar[XB_TOP], 1u);
            const unsigned tg = og / nx;
            if (og + 1u == (tg + 1u) * nx) xb_add(&bar[XB_TOPGEN], 1u);
            else XB_SPIN(xb_ld(&bar[XB_TOPGEN]) == tg, bar);
            __builtin_amdgcn_fence(__ATOMIC_ACQUIRE, "agent");
            xb_add(&bar[XB_XGEN(b.x)], 1u);
            asm volatile("s_waitcnt vmcnt(0)" ::: "memory");
        } else {
            XB_SPIN(xb_ld(&bar[XB_XGEN(b.x)]) == gen, bar);
            __builtin_amdgcn_fence(__ATOMIC_ACQUIRE, "agent");
            asm volatile("s_waitcnt vmcnt(0)" ::: "memory");
        }
    }
    __syncthreads();
}

namespace pg8 {
#define PG8_LAS __attribute__((address_space(3)))
typedef unsigned short bf16_t;
typedef short bf16x8 __attribute__((ext_vector_type(8)));
typedef float f32x4 __attribute__((ext_vector_type(4)));
typedef unsigned u32x4 __attribute__((ext_vector_type(4)));
constexpr int BM = 256, BK = 64, HALF = 128, HTB = HALF * BK * 2  , STAGE_BYTES = 8 * HTB, NXCD = 8, WGM = 8;

__host__ __device__ __forceinline__ int lds_byte(int r, int c) { const int st = (r >> 4) * 2 + (c >> 5), rr = r & 15, cc = c & 31, ob = rr * 64 + cc * 2; return st * 1024 + (ob ^ (((ob >> 9) & 1) << 5)); }
__host__ __device__ __forceinline__ void stage_rc(int b, int& R, int& C) { const int st = b / 1024, sb = b % 1024, swz = sb ^ (((sb >> 9) & 1) << 5); R = (st >> 1) * 16 + swz / 64; C = (st & 1) * 32 + (swz % 64) / 2; }
__host__ __device__ __forceinline__ int perm32(int rho) { const int n = rho >> 4, i = rho & 15; return 8 * (i >> 2) + 4 * n + (i & 3); }

struct Unit { int pm, pn; };
struct Gemm { const bf16_t* A; const bf16_t* Bt; int M, N, K, lda, ldb; };

struct StaticOrder {
    int nM, nN, nwg, G, c;
    __host__ __device__ void init(int M, int N, int G_, int c_) { nM = M / BM; nN = N / BM; nwg = nM * nN; G = G_; c = c_; }
    __host__ __device__ bool next(int i, Unit& u) const {
        const long L = (long)i * G + c; if (L >= nwg) return false;
        int wgid = (int)L; { const int q = nwg / NXCD, r = nwg % NXCD, xcd = wgid % NXCD, off = wgid / NXCD; wgid = (xcd < r ? xcd * (q + 1) : r * (q + 1) + (xcd - r) * q) + off; }
        const int nig = WGM * nN, gid = wgid / nig, fm = gid * WGM, gsz = (nM - fm) < WGM ? (nM - fm) : WGM;
        u.pm = fm + ((wgid % nig) % gsz); u.pn = (wgid % nig) / gsz; return true;
    }
    __device__ __forceinline__ void a_ready(const Unit&) const {}
    __device__ __forceinline__ void done(const Unit&) const {}
};

typedef __bf16 bf16x2_t __attribute__((ext_vector_type(2)));
typedef float f32x2_t __attribute__((ext_vector_type(2)));
__device__ __forceinline__ unsigned cvt_pk_bf16(float lo, float hi) { f32x2_t v = {lo, hi}; bf16x2_t b = __builtin_convertvector(v, bf16x2_t); return __builtin_bit_cast(unsigned, b); }
template <class Epi, class Sched, bool ALIGN_EPI = false, bool SP2 = false>
__device__ __forceinline__ void gemm_phase(PG8_LAS unsigned char* lds, const Gemm g, const Sched& S, const Epi& E) {
    const int tid = threadIdx.x, wid = __builtin_amdgcn_readfirstlane(tid >> 6), lane = tid & 63, wr = wid >> 2, wc = wid & 3, fr = lane & 15, fq = lane >> 4;
    const int K = g.K, nt = K / BK;
    unsigned voffA[2], voffB[2];
#pragma unroll
    for (int i = 0; i < 2; ++i) { int R, C; stage_rc(tid * 16 + i * 8192, R, C); const int Rb = Epi::PERM ? ((R & ~31) + perm32(R & 31)) : R;
        voffA[i] = (unsigned)(R * g.lda + C) * 2u; voffB[i] = (unsigned)(Rb * g.ldb + C) * 2u; }
    const size_t kstep = (size_t)(BK * 2);
    const size_t hstepA = (size_t)HALF * g.lda * 2, hstepB = (size_t)HALF * g.ldb * 2;
    const size_t tstepA = 2 * hstepA, tstepB = 2 * hstepB;
    const unsigned ldsw = (unsigned)wid * 1024u;
    const int aoff = lds_byte(wr * 64 + fr, fq * 8), boff = lds_byte(wc * 32 + fr, fq * 8);
#define PG8_SA(b, h) (((b) * 2 + (h)) * HTB)
#define PG8_SB(b, h) ((4 + (b) * 2 + (h)) * HTB)
#define PG8_STAGE(bufoff, gbase, voff) do { _Pragma("unroll") for (int _i = 0; _i < 2; ++_i) \
        __builtin_amdgcn_global_load_lds((const unsigned*)((const char*)(gbase) + (voff)[_i]), (PG8_LAS unsigned*)(lds + (bufoff) + ldsw + _i * 8192), 16, 0, 0); } while (0)
#define PG8_LDA(dst, b, h) do { _Pragma("unroll") for (int m = 0; m < 4; ++m) _Pragma("unroll") for (int k = 0; k < 2; ++k) dst[m][k] = *(const PG8_LAS bf16x8*)(lds + PG8_SA(b, h) + aoff + m * 2048 + k * 1024); } while (0)
#define PG8_LDB(dst, b, h) do { _Pragma("unroll") for (int n = 0; n < 2; ++n) _Pragma("unroll") for (int k = 0; k < 2; ++k) dst[n][k] = *(const PG8_LAS bf16x8*)(lds + PG8_SB(b, h) + boff + n * 2048 + k * 1024); } while (0)
#define PG8_MMA(ai, bj, At, Bt) do { __builtin_amdgcn_s_setprio(1); _Pragma("unroll") for (int m = 0; m < 4; ++m) _Pragma("unroll") for (int n = 0; n < 2; ++n) _Pragma("unroll") for (int k = 0; k < 2; ++k) \
        acc[ai][bj][m][n] = __builtin_amdgcn_mfma_f32_16x16x32_bf16(Bt[n][k], At[m][k], acc[ai][bj][m][n], 0, 0, 0); __builtin_amdgcn_s_setprio(0); } while (0)
#define PG8_WAIT_V(n) asm volatile("s_waitcnt vmcnt(" #n ")" ::: "memory")
#define PG8_WAIT_L(n) asm volatile("s_waitcnt lgkmcnt(" #n ")" ::: "memory")
#define PG8_BAR __builtin_amdgcn_s_barrier()
#define PG8_SCHED __builtin_amdgcn_sched_barrier(0)
    Unit cur, nxt; int ui = 0;
    if (!S.next(0, cur)) return;
    f32x4 acc[2][2][4][2];
#pragma unroll
    for (int a = 0; a < 2; ++a)
#pragma unroll
        for (int b = 0; b < 2; ++b)
#pragma unroll
            for (int m = 0; m < 4; ++m)
#pragma unroll
                for (int n = 0; n < 2; ++n) acc[a][b][m][n] = (f32x4){0.f, 0.f, 0.f, 0.f};
    bf16x8 At[4][2], B0[2][2], B1[2][2];
    const char* cA = (const char*)g.A + (size_t)cur.pm * tstepA; const char* cB = (const char*)g.Bt + (size_t)cur.pn * tstepB;
    S.a_ready(cur);
    if constexpr (SP2) {
        PG8_STAGE(PG8_SB(0, 0), cB, voffB); PG8_STAGE(PG8_SB(0, 1), cB + hstepB, voffB); PG8_STAGE(PG8_SA(0, 0), cA, voffA); PG8_STAGE(PG8_SA(0, 1), cA + hstepA, voffA);
        if (wr == 1) PG8_BAR;
        PG8_WAIT_V(2); PG8_BAR;
        PG8_STAGE(PG8_SB(1, 0), cB + kstep, voffB); PG8_STAGE(PG8_SA(1, 0), cA + kstep, voffA); PG8_STAGE(PG8_SB(1, 1), cB + hstepB + kstep, voffB);
        PG8_WAIT_V(6); PG8_BAR;
    } else {
        PG8_STAGE(PG8_SB(0, 0), cB, voffB); PG8_STAGE(PG8_SA(0, 0), cA, voffA); PG8_STAGE(PG8_SB(0, 1), cB + hstepB, voffB); PG8_STAGE(PG8_SA(0, 1), cA + hstepA, voffA);
        if (wr == 1) PG8_BAR;
        PG8_WAIT_V(4); PG8_BAR;
        PG8_STAGE(PG8_SB(1, 0), cB + kstep, voffB); PG8_STAGE(PG8_SA(1, 0), cA + kstep, voffA); PG8_STAGE(PG8_SB(1, 1), cB + hstepB + kstep, voffB);
        PG8_WAIT_V(6); PG8_BAR;
    }
    for (;;) {
        const bool has_next = S.next(ui + 1, nxt);
        const char* nA = has_next ? (const char*)g.A + (size_t)nxt.pm * tstepA : cA; const char* nB = has_next ? (const char*)g.Bt + (size_t)nxt.pn * tstepB : cB;
        for (int t = 0; t < nt; t += 2) {
            const bool last = (t == nt - 2);
            const char* a1 = cA + (size_t)(t + 1) * kstep;
            const char* a2 = last ? nA : cA + (size_t)(t + 2) * kstep; const char* b2 = last ? nB : cB + (size_t)(t + 2) * kstep;
            const char* a3 = a2 + kstep; const char* b3 = b2 + kstep;
            if (last && has_next) S.a_ready(nxt);
            if constexpr (SP2) {
            PG8_LDB(B0, 0, 0); PG8_LDB(B1, 0, 1); PG8_SCHED; PG8_LDA(At, 0, 0); PG8_STAGE(PG8_SA(1, 1), a1 + hstepA, voffA);
            PG8_WAIT_V(8); PG8_WAIT_L(0); PG8_BAR; PG8_MMA(0, 0, At, B0); PG8_MMA(0, 1, At, B1); PG8_BAR; PG8_SCHED;
            PG8_LDA(At, 0, 1); PG8_STAGE(PG8_SB(0, 0), b2, voffB); PG8_STAGE(PG8_SB(0, 1), b2 + hstepB, voffB); PG8_STAGE(PG8_SA(0, 0), a2, voffA);
            PG8_WAIT_V(8); PG8_WAIT_L(0); PG8_BAR; PG8_MMA(1, 0, At, B0); PG8_MMA(1, 1, At, B1); PG8_BAR; PG8_SCHED;
            PG8_LDB(B0, 1, 0); PG8_LDB(B1, 1, 1); PG8_SCHED; PG8_LDA(At, 1, 0); PG8_STAGE(PG8_SA(0, 1), a2 + hstepA, voffA);
            PG8_WAIT_V(8); PG8_WAIT_L(0); PG8_BAR; PG8_MMA(0, 0, At, B0); PG8_MMA(0, 1, At, B1); PG8_BAR; PG8_SCHED;
            PG8_LDA(At, 1, 1); PG8_STAGE(PG8_SB(1, 0), b3, voffB); PG8_STAGE(PG8_SB(1, 1), b3 + hstepB, voffB); PG8_STAGE(PG8_SA(1, 0), a3, voffA);
            PG8_WAIT_V(8); PG8_WAIT_L(0); PG8_BAR; PG8_MMA(1, 0, At, B0); PG8_MMA(1, 1, At, B1); PG8_BAR; PG8_SCHED;
            } else {
            PG8_LDB(B0, 0, 0); PG8_SCHED; PG8_LDA(At, 0, 0); PG8_STAGE(PG8_SA(1, 1), a1 + hstepA, voffA);
            PG8_WAIT_L(8); PG8_BAR; PG8_WAIT_L(0); PG8_MMA(0, 0, At, B0); PG8_BAR; PG8_SCHED;
            PG8_LDB(B1, 0, 1); PG8_STAGE(PG8_SB(0, 0), b2, voffB);
            PG8_BAR; PG8_WAIT_L(0); PG8_MMA(0, 1, At, B1); PG8_BAR;
            PG8_LDA(At, 0, 1); PG8_STAGE(PG8_SA(0, 0), a2, voffA);
            PG8_BAR; PG8_WAIT_L(0); PG8_MMA(1, 0, At, B0); PG8_BAR; PG8_SCHED;
            PG8_STAGE(PG8_SB(0, 1), b2 + hstepB, voffB);
            PG8_WAIT_V(6); PG8_BAR; PG8_MMA(1, 1, At, B1); PG8_BAR;
            PG8_LDB(B0, 1, 0); PG8_SCHED; PG8_LDA(At, 1, 0); PG8_STAGE(PG8_SA(0, 1), a2 + hstepA, voffA);
            PG8_WAIT_L(8); PG8_BAR; PG8_WAIT_L(0); PG8_MMA(0, 0, At, B0); PG8_BAR; PG8_SCHED;
            PG8_LDB(B1, 1, 1); PG8_STAGE(PG8_SB(1, 0), b3, voffB);
            PG8_BAR; PG8_WAIT_L(0); PG8_MMA(0, 1, At, B1); PG8_BAR;
            PG8_LDA(At, 1, 1); PG8_STAGE(PG8_SA(1, 0), a3, voffA);
            PG8_BAR; PG8_WAIT_L(0); PG8_MMA(1, 0, At, B0); PG8_BAR; PG8_SCHED;
            PG8_STAGE(PG8_SB(1, 1), b3 + hstepB, voffB);
            PG8_WAIT_V(6); PG8_BAR; PG8_MMA(1, 1, At, B1); PG8_BAR;
            }
        }
        if constexpr (ALIGN_EPI) { if (wr == 0) PG8_BAR; }
        if constexpr (!Epi::AFTER_DRAIN) { E(acc, cur, wr, wc, fr, fq); S.done(cur); }
        if (!has_next) break;
#pragma unroll
        for (int a = 0; a < 2; ++a)
#pragma unroll
            for (int b = 0; b < 2; ++b)
#pragma unroll
                for (int m = 0; m < 4; ++m)
#pragma unroll
                    for (int n = 0; n < 2; ++n) acc[a][b][m][n] = (f32x4){0.f, 0.f, 0.f, 0.f};
        cur = nxt; cA = nA; cB = nB; ++ui;
        if constexpr (ALIGN_EPI) { if (wr == 1) PG8_BAR; }
    }
    PG8_WAIT_V(0);
    if constexpr (!ALIGN_EPI) { if (wr == 0) PG8_BAR; }
    PG8_BAR;
    if constexpr (Epi::AFTER_DRAIN) { E.fused(acc, cur, wr, wc, fr, fq, lds, wid, lane); S.done(cur); }
#undef PG8_SA
#undef PG8_SB
#undef PG8_STAGE
#undef PG8_LDA
#undef PG8_LDB
#undef PG8_MMA
#undef PG8_WAIT_V
#undef PG8_WAIT_L
#undef PG8_BAR
#undef PG8_SCHED
}
}

typedef pg8::f32x4 f32x4;
typedef pg8::u32x4 u32x4;
__device__ __forceinline__ u32x4 pack8(const f32x4& a, const f32x4& b) { u32x4 w; w.x = pg8::cvt_pk_bf16(a[0], a[1]); w.y = pg8::cvt_pk_bf16(a[2], a[3]); w.z = pg8::cvt_pk_bf16(b[0], b[1]); w.w = pg8::cvt_pk_bf16(b[2], b[3]); return w; }
__device__ __forceinline__ void unpack8(const u32x4& w, f32x4& a, f32x4& b) {
    a[0] = __uint_as_float(w.x << 16); a[1] = __uint_as_float(w.x & 0xffff0000u); a[2] = __uint_as_float(w.y << 16); a[3] = __uint_as_float(w.y & 0xffff0000u);
    b[0] = __uint_as_float(w.z << 16); b[1] = __uint_as_float(w.z & 0xffff0000u); b[2] = __uint_as_float(w.w << 16); b[3] = __uint_as_float(w.w & 0xffff0000u); }
__device__ __forceinline__ f32x4 sig4(const f32x4& v) { f32x4 r; r[0] = sigmoidf_(v[0]); r[1] = sigmoidf_(v[1]); r[2] = sigmoidf_(v[2]); r[3] = sigmoidf_(v[3]); return r; }

struct EpiProjM {
    static constexpr bool PERM = true, AFTER_DRAIN = false;
    bf16 *pr, *u, *usamp, *gates; float* out;
    __device__ __forceinline__ void operator()(const f32x4 (&acc)[2][2][4][2], const pg8::Unit& un, int wr, int wc, int fr, int fq) const {
#pragma unroll
        for (int bj = 0; bj < 2; ++bj) {
            const int col = un.pn * 256 + bj * 128 + wc * 32 + 8 * fq;
            if (col >= PROJ) continue;
#pragma unroll
            for (int ai = 0; ai < 2; ++ai)
#pragma unroll
                for (int m = 0; m < 4; ++m) {
                    const int row = un.pm * 256 + ai * 128 + wr * 64 + m * 16 + fr;
                    const f32x4 v0 = acc[ai][bj][m][0], v1 = acc[ai][bj][m][1];
                    if (col < SHIFT) {
                        *(u32x4*)(pr + (size_t)row * SHIFT + col) = pack8(v0, v1);
                        float* o = nullptr;
                        if (row < MP) { if ((row & (T - 1)) == T - 1) o = out + O_SHIFT_P + (size_t)(row / T) * SHIFT + col; }
                        else if (row < M) o = out + O_SHIFT_S + (size_t)(row - MP) * SHIFT + col;
                        if (o) { *(f32x4*)o = v0; *(f32x4*)(o + 4) = v1; }
                    } else if (col < SHIFT + 512) {
                        const int cu = col - SHIFT;
                        if (row < MP) *(u32x4*)(u + ((size_t)((cu >> 4) * 512 + (row >> 11) * 64 + ((row & 2047) >> 5)) * 640 + (row & 31) * 16 + (cu & 15))) = pack8(v0, v1);
                        else if (row < M) *(u32x4*)(usamp + (size_t)(row - MP) * 512 + cu) = pack8(v0, v1);
                    }
                    else *(u32x4*)(gates + (size_t)row * 2048 + (col - SHIFT - 512)) = pack8(sig4(v0), sig4(v1));
                }
        }
    }
};
struct EpiA1M {
    static constexpr bool PERM = true, AFTER_DRAIN = false;
    const bf16* gates; bf16* merged;
    __device__ __forceinline__ void operator()(const f32x4 (&acc)[2][2][4][2], const pg8::Unit& un, int wr, int wc, int fr, int fq) const {
#pragma unroll
        for (int ai = 0; ai < 2; ++ai)
#pragma unroll
            for (int m = 0; m < 4; ++m) {
                const int row = un.pm * 256 + ai * 128 + wr * 64 + m * 16 + fr;
#pragma unroll
                for (int bj = 0; bj < 2; ++bj) {
                    const int col = un.pn * 256 + bj * 128 + wc * 32 + 8 * fq;
                    f32x4 g0, g1; unpack8(*(const u32x4*)(gates + (size_t)row * 2048 + col), g0, g1);
                    *(u32x4*)(merged + (size_t)row * D + col) = pack8(acc[ai][bj][m][0] * g0, acc[ai][bj][m][1] * g1);
                }
            }
    }
};
struct EpiGluM {
    static constexpr bool PERM = true, AFTER_DRAIN = false;
    const bf16* gates; const float *b1, *b2; bf16* merged;
    __device__ __forceinline__ void operator()(const f32x4 (&acc)[2][2][4][2], const pg8::Unit& un, int wr, int wc, int fr, int fq) const {
        const int col = un.pn * 128 + wc * 32 + 8 * fq;
        const f32x4 b1a = *(const f32x4*)(b1 + col), b1b = *(const f32x4*)(b1 + col + 4), b2a = *(const f32x4*)(b2 + col), b2b = *(const f32x4*)(b2 + col + 4);
#pragma unroll
        for (int ai = 0; ai < 2; ++ai)
#pragma unroll
            for (int m = 0; m < 4; ++m) {
                const int row = un.pm * 256 + ai * 128 + wr * 64 + m * 16 + fr;
                f32x4 g0, g1, t0, t1; unpack8(*(const u32x4*)(gates + (size_t)row * 2048 + 1024 + col), g0, g1); unpack8(*(const u32x4*)(merged + (size_t)row * D + col), t0, t1);
                const f32x4 o0 = t0 + g0 * ((acc[ai][0][m][0] + b1a) * sig4(acc[ai][1][m][0] + b2a));
                const f32x4 o1 = t1 + g1 * ((acc[ai][0][m][1] + b1b) * sig4(acc[ai][1][m][1] + b2b));
                *(u32x4*)(merged + (size_t)row * D + col) = pack8(o0, o1);
            }
    }
};
struct EpiF32M {
    static constexpr bool PERM = false, AFTER_DRAIN = false;
    float* o; int ld;
    __device__ __forceinline__ void operator()(const f32x4 (&acc)[2][2][4][2], const pg8::Unit& un, int wr, int wc, int fr, int fq) const {
#pragma unroll
        for (int ai = 0; ai < 2; ++ai)
#pragma unroll
            for (int m = 0; m < 4; ++m) {
                const int row = un.pm * 256 + ai * 128 + wr * 64 + m * 16 + fr;
#pragma unroll
                for (int bj = 0; bj < 2; ++bj)
#pragma unroll
                    for (int n = 0; n < 2; ++n) *(f32x4*)(o + (size_t)row * ld + un.pn * 256 + bj * 128 + wc * 32 + 16 * n + 4 * fq) = acc[ai][bj][m][n];
            }
    }
};
struct EpiSwigluM {
    static constexpr bool PERM = true, AFTER_DRAIN = false;
    bf16* o;
    __device__ __forceinline__ void operator()(const f32x4 (&acc)[2][2][4][2], const pg8::Unit& un, int wr, int wc, int fr, int fq) const {
        const int col = un.pn * 128 + wc * 32 + 8 * fq;
#pragma unroll
        for (int ai = 0; ai < 2; ++ai)
#pragma unroll
            for (int m = 0; m < 4; ++m) {
                const int row = un.pm * 256 + ai * 128 + wr * 64 + m * 16 + fr;
                const f32x4 g0 = acc[ai][0][m][0], g1 = acc[ai][0][m][1];
                *(u32x4*)(o + (size_t)row * FF + col) = pack8(g0 * sig4(g0) * acc[ai][1][m][0], g1 * sig4(g1) * acc[ai][1][m][1]);
            }
    }
};

__device__ __forceinline__ void tr_item(const float* W, int K, int N, bf16* WT, int k0, int n0, int drow0, LAS float* scr, int lane) {
#pragma unroll 8
    for (int i = 0; i < 32; ++i) { const int kk = 2 * i + (lane >> 5); scr[kk * 33 + (lane & 31)] = W[(size_t)(k0 + kk) * N + n0 + (lane & 31)]; }
    asm volatile("s_waitcnt lgkmcnt(0)" ::: "memory");
    const int c = lane & 7;
#pragma unroll
    for (int j = 0; j < 4; ++j) { const int n = (lane >> 3) + 8 * j; const LAS float* s = scr + (8 * c) * 33 + n;
        u32x4 o; o.x = pg8::cvt_pk_bf16(s[0 * 33], s[1 * 33]); o.y = pg8::cvt_pk_bf16(s[2 * 33], s[3 * 33]); o.z = pg8::cvt_pk_bf16(s[4 * 33], s[5 * 33]); o.w = pg8::cvt_pk_bf16(s[6 * 33], s[7 * 33]);
        *(u32x4*)(WT + (size_t)(drow0 + n) * K + k0 + 8 * c) = o; }
    asm volatile("s_waitcnt lgkmcnt(0)" ::: "memory");
}
__device__ __forceinline__ bool tr_seg(int& r, const float* W, int K, int N, bf16* WT, int mode, LAS float* scr, int lane) {
    const int nblk = N / 32, items = (K / 64) * nblk;
    if (r >= items) { r -= items; return false; }
    const int kb = r / nblk, nb = r % nblk, n0 = 32 * nb;
    const int drow0 = mode == 0 ? n0 : 256 * (n0 / 128) + 128 * (mode - 1) + (n0 % 128);
    tr_item(W, K, N, WT, 64 * kb, n0, drow0, scr, lane);
    return true;
}
__device__ __forceinline__ void ph_prologue(const P& p, LAS unsigned char* lds) {
    const int lane = threadIdx.x & 63, wv = threadIdx.x >> 6, gw = blockIdx.x * NWAVES + wv, NGW = gridDim.x * NWAVES;
    LAS float* scr = (LAS float*)(lds + wv * 16384);
    unsigned char* ws = p.ws;
    constexpr int NITEMS = 16 * 132 + 8 * 32 * 3 + 16 * 32 + 16 * 88 * 2 + 44 * 32;
    for (int it = gw; it < NITEMS; it += NGW) {
        int r = it;
        if (tr_seg(r, p.in[10], 1024, PROJ, (bf16*)(ws + WS_WT_IN), 0, scr, lane)) continue;
        if (tr_seg(r, p.in[22], 512, 1024, (bf16*)(ws + WS_WT_RO), 0, scr, lane)) continue;
        if (tr_seg(r, p.in[31], 512, 1024, (bf16*)(ws + WS_WT_GLU), 1, scr, lane)) continue;
        if (tr_seg(r, p.in[33], 512, 1024, (bf16*)(ws + WS_WT_GLU), 2, scr, lane)) continue;
        if (tr_seg(r, p.in[35], 1024, 1024, (bf16*)(ws + WS_WT_MO), 0, scr, lane)) continue;
        if (tr_seg(r, p.in[36], 1024, FF, (bf16*)(ws + WS_WT_GU), 1, scr, lane)) continue;
        if (tr_seg(r, p.in[37], 1024, FF, (bf16*)(ws + WS_WT_GU), 2, scr, lane)) continue;
        tr_seg(r, p.in[38], FF, 1024, (bf16*)(ws + WS_WT_DN), 0, scr, lane);
    }
}
template <class Epi>
__device__ __forceinline__ void ph_mfma_gemm(LAS unsigned char* lds, const bf16* A, const bf16* Bt, int N, int K, const Epi& e) {
    pg8::Gemm g{A, Bt, MPAD, N, K, K, K}; pg8::StaticOrder S; S.init(MPAD, N, (int)gridDim.x, (int)blockIdx.x);
    pg8::gemm_phase<Epi, pg8::StaticOrder, true, true>(lds, g, S, e);
}

__device__ __forceinline__ void ph_xnorm(const P& p) {
    const int lane = threadIdx.x & 63, gw = blockIdx.x * NWAVES + (threadIdx.x >> 6), NGW = gridDim.x * NWAVES;
    const float* g = p.in[6];
    bf16* xn = (bf16*)(p.ws + WS_XN);
    for (int r = gw; r < M; r += NGW) {
        const float* x = xrow(p, r);
        float v[16]; float s = 0.f;
#pragma unroll
        for (int j = 0; j < 16; ++j) { v[j] = x[lane + 64 * j]; s += v[j] * v[j]; }
        s = wave_sum(s);
        const float rs = rsqrtf(s * (1.f / D) + NORM_EPS);
#pragma unroll
        for (int j = 0; j < 16; ++j) xn[(size_t)r * D + lane + 64 * j] = f2bf(v[j] * rs * g[lane + 64 * j]);
    }
}

template <int NW> struct GemmArgs { const bf16* A[NW]; const float* W[NW]; int lda[NW]; int K[NW]; int Mrows, N; };
template <int NW, class Epi>
__device__ __forceinline__ void ph_gemm(const GemmArgs<NW>& g, const Epi& epi, LAS unsigned char* lds) {
    LAS float (*As)[68] = (LAS float (*)[68])lds;
    LAS float (*Ws)[128] = (LAS float (*)[128])(lds + 16 * 68 * 4);
    const int tid = threadIdx.x, tx = tid & 31, ty = tid >> 5;
    const int ntm = (g.Mrows + 63) / 64, ntn = (g.N + 127) / 128;
    for (int t = blockIdx.x; t < ntm * ntn; t += gridDim.x) {
        const int tm = t / ntn, tn = t % ntn;
        float acc[NW][4][4];
#pragma unroll
        for (int w = 0; w < NW; ++w)
#pragma unroll
            for (int i = 0; i < 4; ++i)
#pragma unroll
                for (int j = 0; j < 4; ++j) acc[w][i][j] = 0.f;
#pragma unroll
        for (int w = 0; w < NW; ++w) {
            for (int k0 = 0; k0 < g.K[w]; k0 += 16) {
                __syncthreads();
#pragma unroll
                for (int i = 0; i < 2; ++i) { const int e = tid + 512 * i, r = e >> 4, k = e & 15; const int row = tm * 64 + r;
                    As[k][r] = row < g.Mrows ? bf2f(g.A[w][(size_t)row * g.lda[w] + k0 + k]) : 0.f; }
#pragma unroll
                for (int i = 0; i < 4; ++i) { const int e = tid + 512 * i, k = e >> 7, c = e & 127; const int col = tn * 128 + c;
                    Ws[k][c] = col < g.N ? g.W[w][(size_t)(k0 + k) * g.N + col] : 0.f; }
                __syncthreads();
#pragma unroll
                for (int k = 0; k < 16; ++k) {
                    float a[4], b[4];
#pragma unroll
                    for (int i = 0; i < 4; ++i) a[i] = As[k][ty * 4 + i];
#pragma unroll
                    for (int j = 0; j < 4; ++j) b[j] = Ws[k][tx * 4 + j];
#pragma unroll
                    for (int i = 0; i < 4; ++i)
#pragma unroll
                        for (int j = 0; j < 4; ++j) acc[w][i][j] += a[i] * b[j];
                }
            }
        }
#pragma unroll
        for (int i = 0; i < 4; ++i)
#pragma unroll
            for (int j = 0; j < 4; ++j) {
                const int row = tm * 64 + ty * 4 + i, col = tn * 128 + tx * 4 + j;
                if (row < g.Mrows && col < g.N) {
                    if constexpr (NW == 1) epi(row, col, acc[0][i][j], 0.f, 0.f);
                    else if constexpr (NW == 2) epi(row, col, acc[0][i][j], acc[1][i][j], 0.f);
                    else epi(row, col, acc[0][i][j], acc[1][i][j], acc[2][i][j]);
                }
            }
    }
    __syncthreads();
}
struct EpiProj {
    bf16 *pr, *u, *gates; float* out;
    __device__ void operator()(int row, int col, float x, float, float) const {
        if (col < SHIFT) {
            pr[(size_t)row * SHIFT + col] = f2bf(x);
            if (row < MP) { if ((row % T) == T - 1) out[O_SHIFT_P + (size_t)(row / T) * SHIFT + col] = x; }
            else out[O_SHIFT_S + (size_t)(row - MP) * SHIFT + col] = x;
        } else if (col < SHIFT + 512) u[(size_t)row * 512 + (col - SHIFT)] = f2bf(x);
        else gates[(size_t)row * 2048 + (col - SHIFT - 512)] = f2bf(sigmoidf_(x));
    }
};
struct EpiMerge {
    const bf16* gates; const float *b1, *b2; bf16* merged;
    __device__ void operator()(int row, int col, float v0, float v1, float v2) const {
        const float ga = bf2f(gates[(size_t)row * 2048 + col]), gb = bf2f(gates[(size_t)row * 2048 + 1024 + col]);
        const float glu = (v1 + b1[col]) * sigmoidf_(v2 + b2[col]);
        merged[(size_t)row * D + col] = f2bf(ga * v0 + gb * glu);
    }
};
struct EpiF32 { float* o; int ld; __device__ void operator()(int row, int col, float v0, float, float) const { o[(size_t)row * ld + col] = v0; } };
struct EpiSwiglu { bf16* o; __device__ void operator()(int row, int col, float gt, float up, float) const { o[(size_t)row * FF + col] = f2bf(gt * sigmoidf_(gt) * up); } };

__device__ __forceinline__ void ph_rwkv_item(const P& p, LAS unsigned char* lds, int item) {
    LAS float (*lw)[64] = (LAS float (*)[64])lds;
    const int lane = threadIdx.x & 63, wv = threadIdx.x >> 6;
    const int seq = (item / NH) * NWAVES + wv, h = item % NH;
    const bool prompt = seq < NB;
    const int nT = prompt ? T : 1, row0 = prompt ? seq * T : MP + (seq - NB);
    const int ch = h * HN + lane;
    const bf16* pr = (const bf16*)(p.ws + WS_PR);
    bf16* oa = (bf16*)(p.ws + WS_OA);
    const float* mu = p.in[11];
    __syncthreads();
    if (wv == 0) {
        for (int j = 0; j < 32; ++j) { lw[j][lane] = p.in[13][(size_t)j * RW + ch]; lw[32 + j][lane] = p.in[15][(size_t)j * RW + ch]; }
        for (int j = 0; j < 64; ++j) lw[64 + j][lane] = p.in[16][(size_t)j * RW + ch];
    }
    __syncthreads();
    const float w0 = p.in[12][ch], a0 = p.in[14][ch], kk_w = p.in[17][ch], ka_w = p.in[18][ch], rk_w = p.in[19][ch], lng = p.in[20][ch], lnb = p.in[21][ch];
    const float mu_r = mu[ch], mu_k = mu[RW + ch], mu_v = mu[2 * RW + ch], mu_l1 = mu[3 * RW + lane], mu_l2 = mu[3 * RW + 64 + lane];
    float S[HN];
    float pr_r, pr_k, pr_v, pr_l1, pr_l2;
    if (prompt) {
#pragma unroll
        for (int k = 0; k < HN; ++k) S[k] = 0.f;
        pr_r = pr_k = pr_v = pr_l1 = pr_l2 = 0.f;
    } else {
        const int sb = seq - NB;
        const float* st = p.in[3] + ((size_t)sb * NH + h) * HN * HN + (size_t)lane * HN;
#pragma unroll
        for (int k = 0; k < HN; ++k) S[k] = st[k];
        const float* sh = p.in[2] + (size_t)sb * SHIFT;
        pr_r = sh[ch]; pr_k = sh[RW + ch]; pr_v = sh[2 * RW + ch]; pr_l1 = sh[3 * RW + lane]; pr_l2 = sh[3 * RW + 64 + lane];
    }
    for (int t = 0; t < nT; ++t) {
        const bf16* prow = pr + (size_t)(row0 + t) * SHIFT;
        const float c_r = bf2f(prow[ch]), c_k = bf2f(prow[RW + ch]), c_v = bf2f(prow[2 * RW + ch]), c_l1 = bf2f(prow[3 * RW + lane]), c_l2 = bf2f(prow[3 * RW + 64 + lane]);
        const float r = c_r + (pr_r - c_r) * mu_r, k = c_k + (pr_k - c_k) * mu_k, v = c_v + (pr_v - c_v) * mu_v;
        const float l1 = c_l1 + (pr_l1 - c_l1) * mu_l1, l2 = c_l2 + (pr_l2 - c_l2) * mu_l2;
        pr_r = c_r; pr_k = c_k; pr_v = c_v; pr_l1 = c_l1; pr_l2 = c_l2;
        const float in1 = lane < 32 ? tanhf(l1) : l1;
        const float in2 = sigmoidf_(l2);
        float sw = 0.f, sa_ = 0.f, sg = 0.f;
#pragma unroll 8
        for (int j = 0; j < 32; ++j) { sw += __shfl(in1, j) * lw[j][lane]; sa_ += __shfl(in1, 32 + j) * lw[32 + j][lane]; }
#pragma unroll 8
        for (int j = 0; j < 64; ++j) sg += __shfl(in2, j) * lw[64 + j][lane];
        const float z = -(w0 + sw);
        const float sp = fmaxf(z, 0.f) + log1pf(__expf(-fabsf(z)));
        const float wlog = -sp - 0.5f;
        const float dec = __expf(-__expf(wlog));
        const float a = sigmoidf_(a0 + sa_);
        const float g = sg;
        float kkv = k * kk_w;
        const float nrm = wave_sum(kkv * kkv);
        kkv = kkv * rsqrtf(fmaxf(nrm, 1e-24f));
        const float kp = k * (1.f + (a - 1.f) * ka_w);
        const float bv = kkv * a;
        float sa = 0.f;
#pragma unroll
        for (int kx = 0; kx < HN; ++kx) sa -= S[kx] * __shfl(kkv, kx);
        float o = 0.f;
#pragma unroll
        for (int kx = 0; kx < HN; ++kx) {
            S[kx] = S[kx] * __shfl(dec, kx) + sa * __shfl(bv, kx) + v * __shfl(kp, kx);
            o += S[kx] * __shfl(r, kx);
        }
        const float mean = wave_sum(o) * (1.f / HN);
        const float dlt = o - mean;
        const float var = wave_sum(dlt * dlt) * (1.f / HN);
        float on = dlt * rsqrtf(var + LNX_EPS) * lng + lnb;
        const float bonus = wave_sum(r * kp * rk_w) * v;
        on = (on + bonus) * g;
        oa[(size_t)(row0 + t) * RW + ch] = f2bf(on);
    }
    float* so = prompt ? p.out + O_WKV_P + ((size_t)seq * NH + h) * HN * HN : p.out + O_WKV_S + ((size_t)(seq - NB) * NH + h) * HN * HN;
#pragma unroll
    for (int k = 0; k < HN; ++k) so[(size_t)lane * HN + k] = S[k];
}

__device__ __forceinline__ float gelu_tanh(float x) { const float c = 0.7978845608028654f; return 0.5f * x * (1.f + tanhf(c * (x + 0.044715f * x * x * x))); }
__device__ __forceinline__ void ph_s5_item(const P& p, int item) {
    const int lane = threadIdx.x & 63;
    const int seq = item / SG, g = item % SG;
    const bool prompt = seq < NB;
    const int nT = prompt ? T : 1, row0 = prompt ? seq * T : MP + (seq - NB);
    const bf16* u = (const bf16*)(p.ws + 31 * MiB + 256 * 1024) - (size_t)MP * 512;
    bf16* hgl = (bf16*)(p.ws + WS_HGL);
    const float lre = p.in[23][g * SP + lane], lim = p.in[24][g * SP + lane], dt = __expf(p.in[25][g]);
    const float mag = __expf(lre * dt), ang = lim * dt;
    const float lbr = mag * cosf(ang), lbi = mag * sinf(ang);
    const float nr = lbr - 1.f, ni = lbi, den = lre * lre + lim * lim;
    const float fre = (nr * lre + ni * lim) / den, fim = (ni * lre - nr * lim) / den;
    float bbr[SC], bbi[SC], cr[SC], ci[SC];
#pragma unroll
    for (int c = 0; c < SC; ++c) {
        const float br = p.in[26][((size_t)g * SP + lane) * SC + c], bi = p.in[27][((size_t)g * SP + lane) * SC + c];
        bbr[c] = fre * br - fim * bi; bbi[c] = fre * bi + fim * br;
        cr[c] = p.in[28][((size_t)g * SC + c) * SP + lane]; ci[c] = p.in[29][((size_t)g * SC + c) * SP + lane];
    }
    const float dsk = lane < SC ? p.in[30][g * SC + lane] : 0.f;
    float xr = 0.f, xi = 0.f;
    if (!prompt) { xr = p.in[4][((size_t)(seq - NB) * SG + g) * SP + lane]; xi = p.in[5][((size_t)(seq - NB) * SG + g) * SP + lane]; }
    for (int t = 0; t < nT; ++t) {
        const float uv = lane < SC ? bf2f(u[(size_t)(row0 + t) * 512 + g * SC + lane]) : 0.f;
        float bur = 0.f, bui = 0.f;
#pragma unroll
        for (int c = 0; c < SC; ++c) { const float uc = __shfl(uv, c); bur += bbr[c] * uc; bui += bbi[c] * uc; }
        const float nxr = lbr * xr - lbi * xi + bur, nxi = lbr * xi + lbi * xr + bui;
        xr = nxr; xi = nxi;
        float y = 0.f;
#pragma unroll
        for (int c = 0; c < SC; ++c) { const float s = wave_sum(cr[c] * xr - ci[c] * xi); if (lane == c) y = s; }
        if (lane < SC) { y += dsk * uv; hgl[(size_t)(row0 + t) * 512 + g * SC + lane] = f2bf(gelu_tanh(y)); }
    }
    float* ore = prompt ? p.out + O_S5RE_P + ((size_t)seq * SG + g) * SP : p.out + O_S5RE_S + ((size_t)(seq - NB) * SG + g) * SP;
    float* oim = prompt ? p.out + O_S5IM_P + ((size_t)seq * SG + g) * SP : p.out + O_S5IM_S + ((size_t)(seq - NB) * SG + g) * SP;
    ore[lane] = xr; oim[lane] = xi;
}

__device__ __forceinline__ void ph_row1(const P& p) {
    const int lane = threadIdx.x & 63, gw = blockIdx.x * NWAVES + (threadIdx.x >> 6), NGW = gridDim.x * NWAVES;
    const float *g1 = p.in[7], *g2 = p.in[8];
    const float* mix = (const float*)(p.ws + WS_MIX);
    bf16* h2 = (bf16*)(p.ws + WS_H2);
    for (int r = gw; r < M; r += NGW) {
        const float* x = xrow(p, r);
        float v[16]; float s = 0.f;
#pragma unroll
        for (int j = 0; j < 16; ++j) { v[j] = mix[(size_t)r * D + lane + 64 * j]; s += v[j] * v[j]; }
        s = wave_sum(s);
        const float rs = rsqrtf(s * (1.f / D) + NORM_EPS);
        float s2 = 0.f;
#pragma unroll
        for (int j = 0; j < 16; ++j) { v[j] = x[lane + 64 * j] + v[j] * rs * g1[lane + 64 * j]; s2 += v[j] * v[j]; }
        s2 = wave_sum(s2);
        const float rs2 = rsqrtf(s2 * (1.f / D) + NORM_EPS);
#pragma unroll
        for (int j = 0; j < 16; ++j) { p.out[(size_t)r * D + lane + 64 * j] = v[j]; h2[(size_t)r * D + lane + 64 * j] = f2bf(v[j] * rs2 * g2[lane + 64 * j]); }
    }
}
__device__ __forceinline__ void ph_row2(const P& p) {
    const int lane = threadIdx.x & 63, gw = blockIdx.x * NWAVES + (threadIdx.x >> 6), NGW = gridDim.x * NWAVES;
    const float* g3 = p.in[9];
    const float* f = (const float*)(p.ws + WS_F);
    for (int r = gw; r < M; r += NGW) {
        float v[16]; float s = 0.f;
#pragma unroll
        for (int j = 0; j < 16; ++j) { v[j] = f[(size_t)r * D + lane + 64 * j]; s += v[j] * v[j]; }
        s = wave_sum(s);
        const float rs = rsqrtf(s * (1.f / D) + NORM_EPS);
#pragma unroll
        for (int j = 0; j < 16; ++j) { const size_t i = (size_t)r * D + lane + 64 * j; p.out[i] = p.out[i] + v[j] * rs * g3[lane + 64 * j]; }
    }
}


namespace rk {
typedef short bf16x8 __attribute__((ext_vector_type(8)));
typedef unsigned u32x2 __attribute__((ext_vector_type(2)));
constexpr int LD = 72, SLOT = 64 * LD * 2;
constexpr int LDL = 136;
constexpr int LDF = 68;
constexpr int NCH = T / 64, NUNIT = NB * NCH * NH;
constexpr int F_OFF = 0, M_OFF = 3 * 64 * LDF * 4  , TOT_OFF = M_OFF + 8 * SLOT  ;
static_assert(TOT_OFF + 8 * 64 * 4 <= 131072, "rk lds map");
constexpr size_t WS_WT_LORA = 31 * MiB;
constexpr size_t WS_GT = 33 * MiB, WS_RT = 49 * MiB, WS_S0 = 204 * MiB, WS_CC = 254 * MiB;
constexpr size_t OB_QD = 0, OB_O1 = 16 * MiB, OB_G = 32 * MiB, OB_BV = 48 * MiB;

__device__ __forceinline__ LAS bf16* Fs(LAS unsigned char* lds, int i) { return (LAS bf16*)(lds + F_OFF + i * SLOT); }
__device__ __forceinline__ LAS bf16* Ms(LAS unsigned char* lds, int i) { return (LAS bf16*)(lds + M_OFF + i * SLOT); }
#define RK_BAR() do { asm volatile("s_waitcnt lgkmcnt(0)" ::: "memory"); __syncthreads(); } while (0)

template <int KS>
__device__ __forceinline__ void mm(const LAS bf16* X, int ldx, int kx0, const LAS bf16* Y, int ldy, int ky0, f32x4 (&acc)[2], int rb, int ch, int lane) {
    const int r16 = lane & 15, g = lane >> 4;
#pragma unroll
    for (int s = 0; s < KS; ++s) {
        const bf16x8 a = *(const LAS bf16x8*)(X + (16 * rb + r16) * ldx + kx0 + 32 * s + 8 * g);
#pragma unroll
        for (int j = 0; j < 2; ++j) {
            const bf16x8 b = *(const LAS bf16x8*)(Y + (16 * (2 * ch + j) + r16) * ldy + ky0 + 32 * s + 8 * g);
            acc[j] = __builtin_amdgcn_mfma_f32_16x16x32_bf16(a, b, acc[j], 0, 0, 0);
        }
    }
}
__device__ __forceinline__ void zero2(f32x4 (&a)[2]) { a[0] = (f32x4){0.f, 0.f, 0.f, 0.f}; a[1] = (f32x4){0.f, 0.f, 0.f, 0.f}; }
__device__ __forceinline__ void mask2(f32x4 (&a)[2], int mode, int rb, int ch, int lane) {
    const int c16 = lane & 15, g = lane >> 4;
#pragma unroll
    for (int j = 0; j < 2; ++j)
#pragma unroll
        for (int i = 0; i < 4; ++i) { const int row = 16 * rb + 4 * g + i, col = 16 * (2 * ch + j) + c16; const bool keep = mode == 1 ? col < row : col <= row; if (!keep) a[j][i] = 0.f; }
}
__device__ __forceinline__ void store_nat(LAS bf16* Mx, const f32x4 (&a)[2], int rb, int ch, int lane) {
    const int c16 = lane & 15, g = lane >> 4;
#pragma unroll
    for (int j = 0; j < 2; ++j)
#pragma unroll
        for (int i = 0; i < 4; ++i) Mx[(16 * rb + 4 * g + i) * LD + 16 * (2 * ch + j) + c16] = f2bf(a[j][i]);
}
__device__ __forceinline__ u32x2 pack4(const f32x4& v) { u32x2 w; w.x = pg8::cvt_pk_bf16(v[0], v[1]); w.y = pg8::cvt_pk_bf16(v[2], v[3]); return w; }
__device__ __forceinline__ f32x4 unpack4(const u32x2& w) { f32x4 v; v[0] = __uint_as_float(w.x << 16); v[1] = __uint_as_float(w.x & 0xffff0000u); v[2] = __uint_as_float(w.y << 16); v[3] = __uint_as_float(w.y & 0xffff0000u); return v; }
__device__ __forceinline__ void store_tr(LAS bf16* Mx, const f32x4 (&a)[2], int rb, int ch, int lane) {
    const int c16 = lane & 15, g = lane >> 4;
#pragma unroll
    for (int j = 0; j < 2; ++j) *(LAS u32x2*)(Mx + (16 * (2 * ch + j) + c16) * LD + 16 * rb + 4 * g) = pack4(a[j]);
}
__device__ __forceinline__ void add_nat(const LAS bf16* Mx, f32x4 (&a)[2], int rb, int ch, int lane) {
    const int c16 = lane & 15, g = lane >> 4;
#pragma unroll
    for (int j = 0; j < 2; ++j)
#pragma unroll
        for (int i = 0; i < 4; ++i) a[j][i] += bf2f(Mx[(16 * rb + 4 * g + i) * LD + 16 * (2 * ch + j) + c16]);
}
__device__ __forceinline__ void store_f32(LAS float* Fx, const f32x4 (&a)[2], int rb, int ch, int lane) {
    const int c16 = lane & 15, g = lane >> 4;
#pragma unroll
    for (int j = 0; j < 2; ++j)
#pragma unroll
        for (int i = 0; i < 4; ++i) Fx[(16 * rb + 4 * g + i) * LDF + 16 * (2 * ch + j) + c16] = a[j][i];
}
__device__ __forceinline__ void dump2(unsigned char* base, int unit, const f32x4 (&a)[2], int wv, int lane) {
    u32x2* d = (u32x2*)(base + (size_t)unit * 8192) + (wv * 2) * 64 + lane;
    d[0] = pack4(a[0]); d[64] = pack4(a[1]);
}
__device__ __forceinline__ void undump2(const unsigned char* base, int unit, f32x4 (&a)[2], int wv, int lane) {
    const u32x2* d = (const u32x2*)(base + (size_t)unit * 8192) + (wv * 2) * 64 + lane;
    a[0] = unpack4(d[0]); a[1] = unpack4(d[64]);
}
__device__ __forceinline__ void copy_out(const LAS bf16* Mx, bf16* gl) { const int r = threadIdx.x >> 3, c8 = (threadIdx.x & 7) * 8; *(u32x4*)(gl + r * 64 + c8) = *(const LAS u32x4*)(Mx + r * LD + c8); }
__device__ __forceinline__ void copy_in(LAS bf16* Mx, const bf16* gl) { const int r = threadIdx.x >> 3, c8 = (threadIdx.x & 7) * 8; *(LAS u32x4*)(Mx + r * LD + c8) = *(const u32x4*)(gl + r * 64 + c8); }

__device__ __forceinline__ void prep_unit(const P& p, LAS unsigned char* lds, int unit) {
    const int tid = threadIdx.x, lane = tid & 63, wv = tid >> 6, rb = wv & 3, ch = wv >> 2;
    const int h = unit & 7, bc = unit >> 3, c = bc & (NCH - 1), b = bc / NCH, row0 = b * T + c * 64;
    const bf16* PRb = (const bf16*)(p.ws + WS_PR);
    unsigned char* ob = (unsigned char*)p.out;
    LAS float* FW = (LAS float*)(lds + F_OFF); LAS float* FA = FW + 64 * LDF; LAS float* FG = FA + 64 * LDF;
    LAS bf16* LIN = (LAS bf16*)(lds + M_OFF); LAS bf16* WL = (LAS bf16*)(lds + M_OFF + 2 * SLOT);
    LAS float* TOT = (LAS float*)(lds + TOT_OFF);
    const float* mu = p.in[11];
    const bool first = (c == 0 && wv == 0);
    {
        const bf16* prl = PRb + (size_t)(row0 + 8 * wv) * SHIFT + 3 * RW;
        const float mu0 = mu[3 * RW + lane], mu1 = mu[3 * RW + 64 + lane];
        float p0 = first ? 0.f : bf2f(prl[-SHIFT + lane]), p1 = first ? 0.f : bf2f(prl[-SHIFT + 64 + lane]);
#pragma unroll
        for (int i = 0; i < 8; ++i) {
            const float c0 = bf2f(prl[i * SHIFT + lane]), c1 = bf2f(prl[i * SHIFT + 64 + lane]);
            const float x0 = c0 + (p0 - c0) * mu0, x1 = c1 + (p1 - c1) * mu1; p0 = c0; p1 = c1;
            LIN[(8 * wv + i) * LDL + lane] = f2bf(lane < 32 ? tanhf(x0) : x0);
            LIN[(8 * wv + i) * LDL + 64 + lane] = f2bf(sigmoidf_(x1));
        }
        const bf16* wl = (const bf16*)(p.ws + WS_WT_LORA) + (size_t)(h * 64 + (tid >> 3)) * 128 + (tid & 7) * 16;
        *(LAS u32x4*)(WL + (tid >> 3) * LDL + (tid & 7) * 16) = *(const u32x4*)wl;
        *(LAS u32x4*)(WL + (tid >> 3) * LDL + (tid & 7) * 16 + 8) = *(const u32x4*)(wl + 8);
    }
    RK_BAR();
    {
        f32x4 aw[2], aa[2], ag[2]; zero2(aw); zero2(aa); zero2(ag);
        mm<1>(LIN, LDL, 0, WL, LDL, 0, aw, rb, ch, lane);
        mm<1>(LIN, LDL, 32, WL, LDL, 32, aa, rb, ch, lane);
        mm<2>(LIN, LDL, 64, WL, LDL, 64, ag, rb, ch, lane);
        store_f32(FW, aw, rb, ch, lane); store_f32(FA, aa, rb, ch, lane); store_f32(FG, ag, rb, ch, lane);
    }
    RK_BAR();
    {
        const int cg = h * 64 + lane;
        const float w0 = p.in[12][cg], a0 = p.in[14][cg], kkw = p.in[17][cg], kaw = p.in[18][cg], rkw = p.in[19][cg];
        const float mur = mu[cg], muk = mu[RW + cg], muv = mu[2 * RW + cg];
        const bf16* pr = PRb + (size_t)(row0 + 8 * wv) * SHIFT + cg;
        float pr_r = first ? 0.f : bf2f(pr[-SHIFT]), pr_k = first ? 0.f : bf2f(pr[-SHIFT + RW]), pr_v = first ? 0.f : bf2f(pr[-SHIFT + 2 * RW]);
        float rr[8], kp[8], vv[8], kkv[8], bv[8], ld[8];
        bf16* gout = (bf16*)(ob + OB_G) + (size_t)(row0 + 8 * wv) * RW + cg;
        bf16* bvout = (bf16*)(ob + OB_BV) + (size_t)(row0 + 8 * wv) * RW + cg;
        float run = 0.f;
#pragma unroll
        for (int i = 0; i < 8; ++i) {
            const int row = 8 * wv + i;
            const float c_r = bf2f(pr[i * SHIFT]), c_k = bf2f(pr[i * SHIFT + RW]), c_v = bf2f(pr[i * SHIFT + 2 * RW]);
            const float r_ = c_r + (pr_r - c_r) * mur, k_ = c_k + (pr_k - c_k) * muk, v_ = c_v + (pr_v - c_v) * muv;
            pr_r = c_r; pr_k = c_k; pr_v = c_v;
            const float z = -(w0 + FW[row * LDF + lane]);
            const float sp = fmaxf(z, 0.f) + log1pf(__expf(-fabsf(z)));
            const float l_ = -__expf(-sp - 0.5f);
            const float a_ = sigmoidf_(a0 + FA[row * LDF + lane]);
            float kk_ = k_ * kkw;
            const float nrm = wave_sum(kk_ * kk_);
            kk_ *= rsqrtf(fmaxf(nrm, 1e-24f));
            const float kp_ = k_ * (1.f + (a_ - 1.f) * kaw);
            const float bonus = wave_sum(r_ * kp_ * rkw);
            gout[(size_t)i * RW] = f2bf(FG[row * LDF + lane]);
            bvout[(size_t)i * RW] = f2bf(bonus * v_);
            run += l_;
            rr[i] = r_; kp[i] = kp_; vv[i] = v_; kkv[i] = kk_; bv[i] = kk_ * a_; ld[i] = run;
        }
        TOT[wv * 64 + lane] = run;
        RK_BAR();
        float off = 0.f, tot = 0.f;
#pragma unroll
        for (int w2 = 0; w2 < 8; ++w2) { const float t_ = TOT[w2 * 64 + lane]; tot += t_; if (w2 < wv) off += t_; }
        if (wv == 0) ((float*)(p.ws + WS_CC))[(size_t)unit * 64 + lane] = __expf(tot);
        LAS bf16 *mA = Ms(lds, 0), *mB = Ms(lds, 1), *mK = Ms(lds, 2), *mR = Ms(lds, 3), *mAT = Ms(lds, 4), *mVT = Ms(lds, 5), *mBT = Ms(lds, 6), *mKT = Ms(lds, 7);
        float at[8], vt[8], bt[8], kt[8];
        float prevcl = off;
#pragma unroll
        for (int i = 0; i < 8; ++i) {
            const int row = 8 * wv + i;
            const float cl = off + ld[i];
            const float e_prev = __expf(prevcl), e_neg = __expf(-cl), e_pos = __expf(cl), e_rel = __expf(tot - cl);
            prevcl = cl;
            const float A_ = -kkv[i] * e_prev, B_ = bv[i] * e_neg, K_ = kp[i] * e_neg, R_ = rr[i] * e_pos;
            mA[row * LD + lane] = f2bf(A_); mB[row * LD + lane] = f2bf(B_); mK[row * LD + lane] = f2bf(K_); mR[row * LD + lane] = f2bf(R_);
            at[i] = A_; vt[i] = vv[i]; bt[i] = bv[i] * e_rel; kt[i] = kp[i] * e_rel;
        }
        u32x4 w_;
        w_.x = pg8::cvt_pk_bf16(at[0], at[1]); w_.y = pg8::cvt_pk_bf16(at[2], at[3]); w_.z = pg8::cvt_pk_bf16(at[4], at[5]); w_.w = pg8::cvt_pk_bf16(at[6], at[7]); *(LAS u32x4*)(mAT + lane * LD + 8 * wv) = w_;
        w_.x = pg8::cvt_pk_bf16(vt[0], vt[1]); w_.y = pg8::cvt_pk_bf16(vt[2], vt[3]); w_.z = pg8::cvt_pk_bf16(vt[4], vt[5]); w_.w = pg8::cvt_pk_bf16(vt[6], vt[7]); *(LAS u32x4*)(mVT + lane * LD + 8 * wv) = w_;
        w_.x = pg8::cvt_pk_bf16(bt[0], bt[1]); w_.y = pg8::cvt_pk_bf16(bt[2], bt[3]); w_.z = pg8::cvt_pk_bf16(bt[4], bt[5]); w_.w = pg8::cvt_pk_bf16(bt[6], bt[7]); *(LAS u32x4*)(mBT + lane * LD + 8 * wv) = w_;
        w_.x = pg8::cvt_pk_bf16(kt[0], kt[1]); w_.y = pg8::cvt_pk_bf16(kt[2], kt[3]); w_.z = pg8::cvt_pk_bf16(kt[4], kt[5]); w_.w = pg8::cvt_pk_bf16(kt[6], kt[7]); *(LAS u32x4*)(mKT + lane * LD + 8 * wv) = w_;
    }
    RK_BAR();
    LAS bf16 *mA = Ms(lds, 0), *mB = Ms(lds, 1), *mK = Ms(lds, 2), *mR = Ms(lds, 3), *mAT = Ms(lds, 4), *mVT = Ms(lds, 5), *mBT = Ms(lds, 6), *mKT = Ms(lds, 7);
    f32x4 accQ[2], accN[2], accX[2], accO[2], accS[2], t_[2];
    zero2(accQ); mm<2>(mKT, LD, 0, mVT, LD, 0, accQ, rb, ch, lane);
    zero2(accN); mm<2>(mA, LD, 0, mB, LD, 0, accN, rb, ch, lane); mask2(accN, 1, rb, ch, lane); store_nat(Fs(lds, 0), accN, rb, ch, lane); store_tr(Fs(lds, 1), accN, rb, ch, lane);
    zero2(t_); mm<2>(mA, LD, 0, mK, LD, 0, t_, rb, ch, lane); mask2(t_, 1, rb, ch, lane); store_nat(Fs(lds, 2), t_, rb, ch, lane);
    zero2(t_); mm<2>(mR, LD, 0, mB, LD, 0, t_, rb, ch, lane); mask2(t_, 2, rb, ch, lane); store_nat(Fs(lds, 3), t_, rb, ch, lane);
    zero2(t_); mm<2>(mR, LD, 0, mK, LD, 0, t_, rb, ch, lane); mask2(t_, 2, rb, ch, lane); store_nat(Fs(lds, 4), t_, rb, ch, lane);
    RK_BAR();
    zero2(accS); mm<2>(Fs(lds, 0), LD, 0, Fs(lds, 1), LD, 0, accS, rb, ch, lane); store_nat(mB  , accS, rb, ch, lane); store_tr(mK  , accS, rb, ch, lane);
    zero2(accX); mm<2>(Fs(lds, 2), LD, 0, mVT, LD, 0, accX, rb, ch, lane); store_tr(mKT  , accX, rb, ch, lane);
    zero2(accO); mm<2>(Fs(lds, 4), LD, 0, mVT, LD, 0, accO, rb, ch, lane);
    RK_BAR();
#define RK_NEUMANN(Ncur, Qcur, QTcur, Nnext, Qnext, QTnext, SQUARE) do { \
        accN[0] += accS[0]; accN[1] += accS[1]; mm<2>(Ncur, LD, 0, QTcur, LD, 0, accN, rb, ch, lane); store_nat(Nnext, accN, rb, ch, lane); \
        if (SQUARE) { zero2(t_); mm<2>(Qcur, LD, 0, QTcur, LD, 0, t_, rb, ch, lane); accS[0] = t_[0]; accS[1] = t_[1]; store_nat(Qnext, accS, rb, ch, lane); store_tr(QTnext, accS, rb, ch, lane); } \
        RK_BAR(); } while (0)
    RK_NEUMANN(Fs(lds, 0), mB, mK, Fs(lds, 2), Fs(lds, 4), mVT, true);
    RK_NEUMANN(Fs(lds, 2), Fs(lds, 4), mVT, Fs(lds, 1), mB, mK, true);
    RK_NEUMANN(Fs(lds, 1), mB, mK, Fs(lds, 2), Fs(lds, 4), mVT, true);
    RK_NEUMANN(Fs(lds, 2), Fs(lds, 4), mVT, Fs(lds, 1), mB, mK, true);
    RK_NEUMANN(Fs(lds, 1), mB, mK, Fs(lds, 2), Fs(lds, 4), mVT, false);
#undef RK_NEUMANN
    zero2(t_); mm<2>(Fs(lds, 2), LD, 0, mAT, LD, 0, t_, rb, ch, lane); add_nat(mA, t_, rb, ch, lane); store_tr(Fs(lds, 0), t_, rb, ch, lane);
    mm<2>(Fs(lds, 2), LD, 0, mKT, LD, 0, accX, rb, ch, lane); store_tr(mB  , accX, rb, ch, lane);
    RK_BAR();
    zero2(t_); mm<2>(Fs(lds, 0), LD, 0, mBT, LD, 0, t_, rb, ch, lane); store_tr(mK  , t_, rb, ch, lane);
    mm<2>(mBT, LD, 0, mB  , LD, 0, accQ, rb, ch, lane);
    zero2(t_); mm<2>(Fs(lds, 3), LD, 0, Fs(lds, 0), LD, 0, t_, rb, ch, lane); add_nat(mR, t_, rb, ch, lane); store_nat(mVT  , t_, rb, ch, lane);
    mm<2>(Fs(lds, 3), LD, 0, mB  , LD, 0, accO, rb, ch, lane);
    dump2(ob + OB_QD, unit, accQ, wv, lane); dump2(ob + OB_O1, unit, accO, wv, lane);
    RK_BAR();
    copy_out(mK, (bf16*)(p.ws + WS_GT) + (size_t)unit * 4096);
    copy_out(mVT, (bf16*)(p.ws + WS_RT) + (size_t)unit * 4096);
    RK_BAR();
}

__device__ __forceinline__ void scan_seq(const P& p, LAS unsigned char* lds, int bh) {
    const int tid = threadIdx.x, lane = tid & 63, wv = tid >> 6, rb = wv & 3, ch = wv >> 2, g = lane >> 4;
    const int b = bh >> 3, h = bh & 7;
    LAS bf16* mS = (LAS bf16*)lds;
    LAS bf16* mG[2] = {(LAS bf16*)(lds + SLOT), (LAS bf16*)(lds + 2 * SLOT)};
    const unsigned char* ob = (const unsigned char*)p.out;
    f32x4 acc[2]; zero2(acc);
    store_tr(mS, acc, rb, ch, lane);
    copy_in(mG[0], (const bf16*)(p.ws + WS_GT) + (size_t)((b * NCH) * 8 + h) * 4096);
    RK_BAR();
    for (int n = 0; n < NCH; ++n) {
        const int unit = (b * NCH + n) * 8 + h;
        copy_out(mS, (bf16*)(p.ws + WS_S0) + (size_t)unit * 4096);
        if (n + 1 < NCH) copy_in(mG[(n + 1) & 1], (const bf16*)(p.ws + WS_GT) + (size_t)(unit + 8) * 4096);
        const float* cc = (const float*)(p.ws + WS_CC) + (size_t)unit * 64 + 16 * rb + 4 * g;
        const f32x4 cv = *(const f32x4*)cc;
        f32x4 q[2]; undump2(ob + OB_QD, unit, q, wv, lane);
        acc[0] = acc[0] * cv + q[0]; acc[1] = acc[1] * cv + q[1];
        mm<2>(mG[n & 1], LD, 0, mS, LD, 0, acc, rb, ch, lane);
        RK_BAR();
        store_tr(mS, acc, rb, ch, lane);
        RK_BAR();
    }
    float* so = p.out + O_WKV_P + (size_t)bh * 4096;
#pragma unroll
    for (int j = 0; j < 2; ++j) *(f32x4*)(so + (16 * (2 * ch + j) + (lane & 15)) * 64 + 16 * rb + 4 * g) = acc[j];
}

__device__ __forceinline__ void out_unit(const P& p, LAS unsigned char* lds, int unit) {
    const int tid = threadIdx.x, lane = tid & 63, wv = tid >> 6, rb = wv & 3, ch = wv >> 2;
    const int h = unit & 7, bc = unit >> 3, c = bc & (NCH - 1), b = bc / NCH, row0 = b * T + c * 64;
    LAS bf16* mR = (LAS bf16*)lds; LAS bf16* mS = (LAS bf16*)(lds + SLOT); LAS float* OF = (LAS float*)(lds + 2 * SLOT);
    const unsigned char* ob = (const unsigned char*)p.out;
    copy_in(mR, (const bf16*)(p.ws + WS_RT) + (size_t)unit * 4096);
    copy_in(mS, (const bf16*)(p.ws + WS_S0) + (size_t)unit * 4096);
    f32x4 acc[2]; undump2(ob + OB_O1, unit, acc, wv, lane);
    RK_BAR();
    mm<2>(mR, LD, 0, mS, LD, 0, acc, rb, ch, lane);
    store_f32(OF, acc, rb, ch, lane);
    RK_BAR();
    const int cg = h * 64 + lane;
    const float lng = p.in[20][cg], lnb = p.in[21][cg];
    const bf16* gin = (const bf16*)(ob + OB_G) + (size_t)(row0 + 8 * wv) * RW + cg;
    const bf16* bvin = (const bf16*)(ob + OB_BV) + (size_t)(row0 + 8 * wv) * RW + cg;
    bf16* oa = (bf16*)(p.ws + WS_OA) + (size_t)(row0 + 8 * wv) * RW + cg;
#pragma unroll
    for (int i = 0; i < 8; ++i) {
        const float o = OF[(8 * wv + i) * LDF + lane];
        const float mean = wave_sum(o) * (1.f / 64.f);
        const float d = o - mean;
        const float var = wave_sum(d * d) * (1.f / 64.f);
        const float on = d * rsqrtf(var + LNX_EPS) * lng + lnb;
        oa[(size_t)i * RW] = f2bf((on + bf2f(bvin[(size_t)i * RW])) * bf2f(gin[(size_t)i * RW]));
    }
    RK_BAR();
}
__device__ __forceinline__ void lora_transpose(const P& p) {
    bf16* wl = (bf16*)(p.ws + WS_WT_LORA);
    for (int e = blockIdx.x * NTHR + threadIdx.x; e < 512 * 128; e += gridDim.x * NTHR) {
        const int chn = e >> 7, j = e & 127;
        const float v = j < 32 ? p.in[13][(size_t)j * RW + chn] : j < 64 ? p.in[15][(size_t)(j - 32) * RW + chn] : p.in[16][(size_t)(j - 64) * RW + chn];
        wl[e] = f2bf(v);
    }
}
}

namespace s5 {
constexpr int L = 32, NCHK = T / L  , KU = L * SC  , KA = KU + 2 * SP  , ROWS = NB * NCHK  ;
constexpr size_t WS_US5 = 119 * MiB;
constexpr size_t WS_USAMP = 31 * MiB + 256 * 1024;
constexpr size_t WS_MF = 66 * MiB;
constexpr size_t WS_E = 86 * MiB;
constexpr size_t WS_XE = 94 * MiB;
typedef float f32x2 __attribute__((ext_vector_type(2)));

__device__ __forceinline__ f32x2 cmul(f32x2 a, f32x2 b) { return (f32x2){a.x * b.x - a.y * b.y, a.x * b.y + a.y * b.x}; }

__device__ __forceinline__ void gen_item(const P& p, LAS unsigned char* lds, int g) {
    const int tid = threadIdx.x;
    LAS f32x2* PW = (LAS f32x2*)lds;
    LAS f32x2* BB = PW + 33 * 64;
    LAS f32x2* CM = BB + 64 * 16;
    LAS float* KT = (LAS float*)(CM + 16 * 64);
    __syncthreads();
    {
        const int pp = tid & 63, part = tid >> 6;
        const float lre = p.in[23][g * SP + pp], lim = p.in[24][g * SP + pp], dt = __expf(p.in[25][g]);
        for (int tau = part; tau <= L; tau += 8) { const float m = __expf(tau * lre * dt), a = tau * lim * dt; PW[tau * 64 + pp] = (f32x2){m * cosf(a), m * sinf(a)}; }
        const float mag = __expf(lre * dt), ang = lim * dt;
        const float lbr = mag * cosf(ang), lbi = mag * sinf(ang), nr = lbr - 1.f, ni = lbi, den = lre * lre + lim * lim;
        const f32x2 f = {(nr * lre + ni * lim) / den, (ni * lre - nr * lim) / den};
#pragma unroll
        for (int q = 0; q < 2; ++q) { const int cc = part * 2 + q;
            BB[pp * 16 + cc] = cmul(f, (f32x2){p.in[26][((size_t)g * SP + pp) * SC + cc], p.in[27][((size_t)g * SP + pp) * SC + cc]});
            CM[cc * 64 + pp] = (f32x2){p.in[28][((size_t)g * SC + cc) * SP + pp], p.in[29][((size_t)g * SC + cc) * SP + pp]}; }
    }
    __syncthreads();
    {
        const int cc = tid & 255, c = cc >> 4, c2 = cc & 15, half = tid >> 8;
        for (int tau = half; tau < L; tau += 2) {
            float acc = 0.f;
#pragma unroll 8
            for (int pp = 0; pp < 64; ++pp) { const f32x2 z = cmul(CM[c * 64 + pp], PW[tau * 64 + pp]); const f32x2 bq = BB[pp * 16 + c2]; acc += z.x * bq.x - z.y * bq.y; }
            KT[tau * 256 + cc] = acc;
        }
    }
    __syncthreads();
    bf16* MF = (bf16*)(p.ws + WS_MF) + (size_t)g * 512 * KA;
    for (int idx = tid; idx < 512 * (KA / 8); idx += NTHR) {
        const int n = idx / (KA / 8), kc = idx % (KA / 8), t = n >> 4, c = n & 15;
        float v[8];
        if (kc < 64) { const int j = kc >> 1, c0 = (kc & 1) * 8;
#pragma unroll
            for (int e = 0; e < 8; ++e) v[e] = j <= t ? KT[(t - j) * 256 + c * 16 + c0 + e] : 0.f;
        } else {
#pragma unroll
            for (int e = 0; e < 8; ++e) { const int q = (kc - 64) * 8 + e, pp = q & 63; const f32x2 z = cmul(CM[c * 64 + pp], PW[(t + 1) * 64 + pp]); v[e] = (q >> 6) ? -z.y : z.x; }
        }
        u32x4 w; w.x = pg8::cvt_pk_bf16(v[0], v[1]); w.y = pg8::cvt_pk_bf16(v[2], v[3]); w.z = pg8::cvt_pk_bf16(v[4], v[5]); w.w = pg8::cvt_pk_bf16(v[6], v[7]);
        *(u32x4*)(MF + (size_t)n * KA + kc * 8) = w;
    }
    bf16* E = (bf16*)(p.ws + WS_E) + (size_t)g * 256 * KU;
    for (int idx = tid; idx < 128 * (KU / 8); idx += NTHR) {
        const int r = idx >> 6, kc = idx & 63, pp = r & 63, j = kc >> 1, c0 = (kc & 1) * 8;
        float v[8];
#pragma unroll
        for (int e = 0; e < 8; ++e) { const f32x2 z = cmul(PW[(L - 1 - j) * 64 + pp], BB[pp * 16 + c0 + e]); v[e] = (r >> 6) ? z.y : z.x; }
        u32x4 w; w.x = pg8::cvt_pk_bf16(v[0], v[1]); w.y = pg8::cvt_pk_bf16(v[2], v[3]); w.z = pg8::cvt_pk_bf16(v[4], v[5]); w.w = pg8::cvt_pk_bf16(v[6], v[7]);
        *(u32x4*)(E + (size_t)r * KU + kc * 8) = w;
    }
    __syncthreads();
}

struct GroupOrder {
    int nn, total, G, c;
    __device__ void init(int nn_, int G_, int c_) { nn = nn_; total = SG * 2 * nn_; G = G_; c = c_; }
    __device__ bool next(int i, pg8::Unit& u) const {
        const long Lx = (long)i * G + c; if (Lx >= total) return false;
        const int g = (int)Lx / (2 * nn), rem = (int)Lx % (2 * nn);
        u.pm = 2 * g + rem / nn; u.pn = nn * g + rem % nn; return true;
    }
    __device__ __forceinline__ void a_ready(const pg8::Unit&) const {}
    __device__ __forceinline__ void done(const pg8::Unit&) const {}
};
struct EpiXe {
    static constexpr bool PERM = false, AFTER_DRAIN = false;
    float* xe;
    __device__ __forceinline__ void operator()(const f32x4 (&acc)[2][2][4][2], const pg8::Unit& un, int wr, int wc, int fr, int fq) const {
#pragma unroll
        for (int ai = 0; ai < 2; ++ai)
#pragma unroll
            for (int m = 0; m < 4; ++m) { const int rg = un.pm * 256 + ai * 128 + wr * 64 + m * 16 + fr;
#pragma unroll
                for (int n = 0; n < 2; ++n) *(f32x4*)(xe + (size_t)rg * 128 + wc * 32 + 16 * n + 4 * fq) = acc[ai][0][m][n]; }
    }
};
__device__ __forceinline__ float gelu_fast(float x) { const float z2 = 1.5957691216057308f * (x + 0.044715f * x * x * x); return x / (1.f + __expf(-z2)); }
struct EpiS5Y {
    static constexpr bool PERM = true, AFTER_DRAIN = false;
    const bf16* us5; const float* dsk; bf16* hgl;
    __device__ __forceinline__ void operator()(const f32x4 (&acc)[2][2][4][2], const pg8::Unit& un, int wr, int wc, int fr, int fq) const {
#pragma unroll
        for (int bj = 0; bj < 2; ++bj) {
            const int nl = (un.pn & 1) * 256 + bj * 128 + wc * 32 + 8 * fq, t = nl >> 4, c0 = nl & 15;
#pragma unroll
            for (int ai = 0; ai < 2; ++ai)
#pragma unroll
                for (int m = 0; m < 4; ++m) {
                    const int rg = un.pm * 256 + ai * 128 + wr * 64 + m * 16 + fr, g = rg >> 9, r = rg & 511, tok = (r >> 6) * T + (r & 63) * L + t;
                    f32x4 u0, u1; unpack8(*(const u32x4*)(us5 + (size_t)rg * KA + nl), u0, u1);
                    const f32x4 d0 = *(const f32x4*)(dsk + g * 16 + c0), d1 = *(const f32x4*)(dsk + g * 16 + c0 + 4);
                    f32x4 y0 = acc[ai][bj][m][0] + d0 * u0, y1 = acc[ai][bj][m][1] + d1 * u1;
#pragma unroll
                    for (int e = 0; e < 4; ++e) { y0[e] = gelu_fast(y0[e]); y1[e] = gelu_fast(y1[e]); }
                    *(u32x4*)(hgl + (size_t)tok * 512 + g * 16 + c0) = pack8(y0, y1);
                }
        }
    }
};
__device__ __forceinline__ void carry(const P& p) {
    const int lane = threadIdx.x & 63, wv = threadIdx.x >> 6;
    if (wv != 0) return;
    for (int gb = blockIdx.x; gb < SG * NB; gb += gridDim.x) {
        const int g = gb >> 3, b = gb & 7;
        const float* xe = (const float*)(p.ws + WS_XE) + (size_t)(g * ROWS + b * NCHK) * 128 + lane;
        float xr[NCHK], xi[NCHK];
#pragma unroll
        for (int m = 0; m < NCHK; ++m) { xr[m] = xe[m * 128]; xi[m] = xe[m * 128 + 64]; }
        const float lre = p.in[23][g * SP + lane], lim = p.in[24][g * SP + lane], dt = __expf(p.in[25][g]);
        const float mg = __expf(L * lre * dt), an = L * lim * dt, cr = mg * cosf(an), ci = mg * sinf(an);
        bf16* xc = (bf16*)(p.ws + WS_US5) + (size_t)(g * ROWS + b * NCHK) * KA + KU + lane;
        float sr = 0.f, si = 0.f;
#pragma unroll
        for (int n = 0; n < NCHK; ++n) {
            xc[(size_t)n * KA] = f2bf(sr); xc[(size_t)n * KA + 64] = f2bf(si);
            const float tr = cr * sr - ci * si + xr[n]; si = cr * si + ci * sr + xi[n]; sr = tr;
        }
        p.out[O_S5RE_P + (size_t)(b * SG + g) * SP + lane] = sr;
        p.out[O_S5IM_P + (size_t)(b * SG + g) * SP + lane] = si;
    }
}
}

constexpr int N_PHASES = 14;
__global__ void __launch_bounds__(NTHR, 2) mk_fwd(P p) {
    extern __shared__ __attribute__((aligned(16))) unsigned char lds_raw[];
    LAS unsigned char* lds = (LAS unsigned char*)lds_raw;
    volatile LAS unsigned* MISC = (volatile LAS unsigned*)(lds + MISC_OFF);
    for (int u = threadIdx.x; u < (LDS_BYTES - 131072) / 4; u += NTHR) ((LAS unsigned*)(lds + 131072))[u] = 0u;
    __syncthreads();
    unsigned* ctl = (unsigned*)(p.ws + WS_CTL);
    XcdBarrier bar = xcd_barrier_post(ctl + CW_BAR, MISC + 8);
    const int lo = p.ph_lo, hi = p.ph_hi;
    unsigned char* ws = p.ws;
#define IN(k) (lo <= (k) && (k) < hi)
#define SEAM(k) do { if (IN(k) && IN((k) + 1)) xcd_barrier(bar); } while (0)
    if (IN(0)) { ph_prologue(p, lds); rk::lora_transpose(p); ph_xnorm(p); }
    SEAM(0);
    if (IN(1)) { EpiProjM e{(bf16*)(ws + WS_PR), (bf16*)(ws + s5::WS_US5), (bf16*)(ws + s5::WS_USAMP), (bf16*)(ws + WS_GATES), p.out};
        ph_mfma_gemm(lds, (const bf16*)(ws + WS_XN), (const bf16*)(ws + WS_WT_IN), 4352, 1024, e); }
    SEAM(1);
    if (IN(2)) {
        for (int unit = blockIdx.x; unit < rk::NUNIT; unit += gridDim.x) rk::prep_unit(p, lds, unit);
        for (int item = NH + blockIdx.x; item < ((NB + NS) / NWAVES) * NH; item += gridDim.x) ph_rwkv_item(p, lds, item);
        const int gw = blockIdx.x * NWAVES + (threadIdx.x >> 6), NGW = gridDim.x * NWAVES;
        for (int it = NB * SG + gw; it < (NB + NS) * SG; it += NGW) ph_s5_item(p, it);
    }
    SEAM(2);
    if (IN(3)) {
        if (blockIdx.x < NB * NH) rk::scan_seq(p, lds, blockIdx.x);
        else for (int g = blockIdx.x - NB * NH; g < SG; g += gridDim.x - NB * NH) s5::gen_item(p, lds, g);
    }
    SEAM(3);
    if (IN(4)) {
        { pg8::Gemm g{(const bf16*)(ws + s5::WS_US5), (const bf16*)(ws + s5::WS_E), SG * 512, SG * 256, s5::KU, s5::KA, s5::KU};
          s5::GroupOrder S; S.init(1, (int)gridDim.x, (int)((blockIdx.x + 64) % gridDim.x)); s5::EpiXe e{(float*)(ws + s5::WS_XE)};
          pg8::gemm_phase<s5::EpiXe, s5::GroupOrder, true, true>(lds, g, S, e); }
        for (int unit = blockIdx.x; unit < rk::NUNIT; unit += gridDim.x) rk::out_unit(p, lds, unit);
    }
    SEAM(4);
    if (IN(5)) s5::carry(p);
    SEAM(5);
    if (IN(6)) { pg8::Gemm g{(const bf16*)(ws + s5::WS_US5), (const bf16*)(ws + s5::WS_MF), SG * 512, SG * 512, s5::KA, s5::KA, s5::KA};
        s5::GroupOrder S; S.init(2, (int)gridDim.x, (int)blockIdx.x); s5::EpiS5Y e{(const bf16*)(ws + s5::WS_US5), p.in[30], (bf16*)(ws + WS_HGL)};
        pg8::gemm_phase<s5::EpiS5Y, s5::GroupOrder, true, true>(lds, g, S, e); }
    SEAM(6);
    if (IN(7)) { EpiA1M e{(const bf16*)(ws + WS_GATES), (bf16*)(ws + WS_MERGED)};
        ph_mfma_gemm(lds, (const bf16*)(ws + WS_OA), (const bf16*)(ws + WS_WT_RO), 1024, 512, e); }
    SEAM(7);
    if (IN(8)) { EpiGluM e{(const bf16*)(ws + WS_GATES), p.in[32], p.in[34], (bf16*)(ws + WS_MERGED)};
        ph_mfma_gemm(lds, (const bf16*)(ws + WS_HGL), (const bf16*)(ws + WS_WT_GLU), 2048, 512, e); }
    SEAM(8);
    if (IN(9)) { EpiF32M e{(float*)(ws + WS_MIX), D};
        ph_mfma_gemm(lds, (const bf16*)(ws + WS_MERGED), (const bf16*)(ws + WS_WT_MO), 1024, 1024, e); }
    SEAM(9);
    if (IN(10)) ph_row1(p);
    SEAM(10);
    if (IN(11)) { EpiSwigluM e{(bf16*)(ws + WS_HFF)};
        ph_mfma_gemm(lds, (const bf16*)(ws + WS_H2), (const bf16*)(ws + WS_WT_GU), 5632, 1024, e); }
    SEAM(11);
    if (IN(12)) { EpiF32M e{(float*)(ws + WS_F), D};
        ph_mfma_gemm(lds, (const bf16*)(ws + WS_HFF), (const bf16*)(ws + WS_WT_DN), 1024, FF, e); }
    SEAM(12);
    if (IN(13)) ph_row2(p);
#undef IN
#undef SEAM
}

#ifndef MK_N_LAUNCHES
#define MK_N_LAUNCHES 1
#endif
extern "C" void kernel_launch(void* const* d_in, const int* in_sizes, int n_in, void* d_out, int out_size, void* d_ws, size_t ws_size, hipStream_t stream) {
    static int grid = 0;
    if (grid == 0) {
        if (n_in != 39 || out_size != (int)O_END || ws_size < 256 * MiB) { fprintf(stderr, "kernel_launch: unexpected sizes n_in %d out %d ws %zu\n", n_in, out_size, ws_size); grid = -1; return; }
        int dev = 0, cus = 0;
        if (hipGetDevice(&dev) != hipSuccess || hipDeviceGetAttribute(&cus, hipDeviceAttributeMultiprocessorCount, dev) != hipSuccess) { grid = -1; return; }
        if (hipFuncSetAttribute((const void*)mk_fwd, hipFuncAttributeMaxDynamicSharedMemorySize, LDS_BYTES) != hipSuccess) { fprintf(stderr, "kernel_launch: hipFuncSetAttribute failed\n"); grid = -1; return; }
        grid = cus;
    }
    if (grid < 0) return;
    if (hipMemsetAsync((char*)d_ws + WS_CTL, 0, CTL_ZERO_BYTES, stream) != hipSuccess) return;
    P p{};
    for (int i = 0; i < 39; ++i) p.in[i] = (const float*)d_in[i];
    p.out = (float*)d_out; p.ws = (unsigned char*)d_ws;
    if (MK_N_LAUNCHES == 1) { p.ph_lo = 0; p.ph_hi = N_PHASES; hipLaunchKernelGGL(mk_fwd, dim3(grid), dim3(NTHR), LDS_BYTES, stream, p); }
    else for (int k = 0; k < N_PHASES; ++k) { p.ph_lo = k; p.ph_hi = k + 1; hipLaunchKernelGGL(mk_fwd, dim3(grid), dim3(NTHR), LDS_BYTES, stream, p); }
}
```
